# Optimizing an MI355X kernel written in HIP

```python
import jax, jax.numpy as jnp
from jax import lax
import numpy as np

D_MODEL = 4096
BATCH = 1
SEQ = 16384
DEPTH = 1

ATTN_HEADS = D_MODEL // 256
HEAD_DIM = 128
ATTN_WIDTH = ATTN_HEADS * HEAD_DIM
MOBA_BLOCK = 256
MOBA_TOPK = 3
MOBA_Q_CHUNK = 64
ROPE_THETA = 10000.0
SGU_GROUPS = D_MODEL // 256
SGU_GROUP_DIM = 128
SGU_WIDTH = SGU_GROUPS * SGU_GROUP_DIM
SGU_CHUNK = 128
IN_WIDTH = 3 * ATTN_WIDTH + 2 * SGU_WIDTH
N_BRANCHES = 2
PEER_HEADS = 8
PEER_N_KEYS = 128
PEER_N_EXPERTS = PEER_N_KEYS * PEER_N_KEYS
PEER_TOPK = 16
PEER_KEY_HALF = 128
PEER_TOKEN_CHUNK = 128
RMS_EPS = 1e-6

kernel_name = 'hybrid_moba_sgu_peer_block'


def rms_norm(x, g):
    xf = x.astype(jnp.float32)
    y = xf * lax.rsqrt(jnp.mean(xf * xf, axis=-1, keepdims=True) + RMS_EPS)
    return (y * g.astype(jnp.float32)).astype(x.dtype)


def rope_tables(seq):
    half = HEAD_DIM // 2
    inv_freq = jnp.power(ROPE_THETA, -jnp.arange(half, dtype=jnp.float32) * (2.0 / HEAD_DIM))
    ang = jnp.arange(seq, dtype=jnp.float32)[:, None] * inv_freq[None, :]
    return jnp.cos(ang), jnp.sin(ang)


def apply_rope(x, cos, sin):
    xf = x.astype(jnp.float32)
    x1, x2 = jnp.split(xf, 2, axis=-1)
    c = cos[None, :, None, :]
    s = sin[None, :, None, :]
    return jnp.concatenate([x1 * c - x2 * s, x2 * c + x1 * s], axis=-1).astype(x.dtype)


def moba_attention(q, k, v):
    B, S, H, Dh = q.shape
    nb = -(-S // MOBA_BLOCK)
    pad = nb * MOBA_BLOCK - S
    k = jnp.pad(k, ((0, 0), (0, pad), (0, 0), (0, 0)))
    v = jnp.pad(v, ((0, 0), (0, pad), (0, 0), (0, 0)))
    kb = k.reshape(B, nb, MOBA_BLOCK, H, Dh).transpose(0, 3, 1, 2, 4)
    vb = v.reshape(B, nb, MOBA_BLOCK, H, Dh).transpose(0, 3, 1, 2, 4)
    k_mean = jnp.mean(kb.astype(jnp.float32), axis=3).astype(k.dtype)
    n_sel = min(MOBA_TOPK, nb)
    nqc = S // MOBA_Q_CHUNK
    qc = q.reshape(B, nqc, MOBA_Q_CHUNK, H, Dh)
    scale = HEAD_DIM ** -0.5
    head_ix = jnp.arange(H)[None, :, None]

    def one_chunk(bc):
        b, c = bc
        qx = qc[b, c]
        kx = kb[b]
        vx = vb[b]
        own = (c * MOBA_Q_CHUNK) // MOBA_BLOCK
        gate = jnp.einsum('qhd,hnd->qhn', qx, k_mean[b]).astype(jnp.float32)
        gate = jnp.where((jnp.arange(nb) < own)[None, None, :], gate, -jnp.inf)
        _, sel = lax.top_k(gate, n_sel)
        valid = jnp.arange(n_sel) < own
        k_sel = kx[head_ix, sel]
        v_sel = vx[head_ix, sel]
        s_past = jnp.einsum('qhd,qhnsd->qhns', qx, k_sel).astype(jnp.float32) * scale
        s_past = jnp.where(valid[None, None, :, None], s_past, -jnp.inf)
        s_past = s_past.reshape(MOBA_Q_CHUNK, H, n_sel * MOBA_BLOCK)
        k_own = lax.dynamic_index_in_dim(kx, own, axis=1, keepdims=False)
        v_own = lax.dynamic_index_in_dim(vx, own, axis=1, keepdims=False)
        s_own = jnp.einsum('qhd,hsd->qhs', qx, k_own).astype(jnp.float32) * scale
        q_pos = c * MOBA_Q_CHUNK + jnp.arange(MOBA_Q_CHUNK)
        k_pos = own * MOBA_BLOCK + jnp.arange(MOBA_BLOCK)
        s_own = jnp.where((k_pos[None, :] <= q_pos[:, None])[:, None, :], s_own, -jnp.inf)
        p = jax.nn.softmax(jnp.concatenate([s_past, s_own], axis=-1), axis=-1).astype(v.dtype)
        p_past = p[..., :n_sel * MOBA_BLOCK].reshape(MOBA_Q_CHUNK, H, n_sel, MOBA_BLOCK)
        p_own = p[..., n_sel * MOBA_BLOCK:]
        return (jnp.einsum('qhns,qhnsd->qhd', p_past, v_sel)
                + jnp.einsum('qhs,hsd->qhd', p_own, v_own))

    b_ix = jnp.repeat(jnp.arange(B), nqc)
    c_ix = jnp.tile(jnp.arange(nqc), B)
    out = lax.map(one_chunk, (b_ix, c_ix))
    return out.reshape(B, S, H * Dh)


def spatial_gating(zu, zv, norm_g, w_s, b_s):
    B, S, _ = zu.shape
    u = jax.nn.gelu(zu)
    vv = rms_norm(jax.nn.gelu(zv).reshape(B, S, SGU_GROUPS, SGU_GROUP_DIM), norm_g)
    nc = S // SGU_CHUNK
    vv = vv.reshape(B, nc, SGU_CHUNK, SGU_GROUPS, SGU_GROUP_DIM)
    causal = jnp.tril(jnp.ones((SGU_CHUNK, SGU_CHUNK), dtype=w_s.dtype))
    mixed = jnp.einsum('gts,bcsgd->bctgd', w_s * causal[None], vv) + b_s.T[None, None, :, :, None]
    return u * mixed.reshape(B, S, SGU_WIDTH)


def peer_ffn(h, wq, subkeys, u_tab, v_tab):
    B, S, D = h.shape
    T = B * S
    ht = h.reshape(T, D)
    q = (ht @ wq).reshape(T, PEER_HEADS, 2, PEER_KEY_HALF)
    s = jnp.einsum('thpd,hpnd->thpn', q, subkeys).astype(jnp.float32)
    s_top, i_top = lax.top_k(s, PEER_TOPK)
    cand = s_top[:, :, 0, :, None] + s_top[:, :, 1, None, :]
    cand_idx = i_top[:, :, 0, :, None] * PEER_N_KEYS + i_top[:, :, 1, None, :]
    cand = cand.reshape(T, PEER_HEADS, PEER_TOPK * PEER_TOPK)
    cand_idx = cand_idx.reshape(T, PEER_HEADS, PEER_TOPK * PEER_TOPK)
    best, pos = lax.top_k(cand, PEER_TOPK)
    experts = jnp.take_along_axis(cand_idx, pos, axis=-1)
    gates = jax.nn.softmax(best, axis=-1)
    nch = T // PEER_TOKEN_CHUNK

    def one_chunk(args):
        hx, ex, gx = args
        u_sel = u_tab[ex]
        act = jax.nn.gelu(jnp.einsum('td,thkd->thk', hx, u_sel))
        w = gx.astype(hx.dtype) * act
        return jnp.einsum('thk,thkd->td', w, v_tab[ex])

    out = lax.map(one_chunk, (ht.reshape(nch, PEER_TOKEN_CHUNK, D),
                              experts.reshape(nch, PEER_TOKEN_CHUNK, PEER_HEADS, PEER_TOPK),
                              gates.reshape(nch, PEER_TOKEN_CHUNK, PEER_HEADS, PEER_TOPK)))
    return out.reshape(B, S, D)


def setup_inputs(seed: int = 0) -> dict:
    key = jax.random.key(seed)
    ks = jax.random.split(key, 17)
    L = DEPTH

    def nrm(k, shape, scale):
        return scale * jax.random.normal(k, shape, dtype=jnp.float32)

    return {
        'x': nrm(ks[0], (BATCH, SEQ, D_MODEL), 1.0),
        'norm_mix_g': 1.0 + nrm(ks[1], (L, D_MODEL), 0.01),
        'w_in': nrm(ks[2], (L, D_MODEL, IN_WIDTH), D_MODEL ** -0.5),
        'w_attn_proj': nrm(ks[3], (L, ATTN_WIDTH, D_MODEL), ATTN_WIDTH ** -0.5),
        'sgu_norm_g': 1.0 + nrm(ks[4], (L, SGU_GROUPS, SGU_GROUP_DIM), 0.01),
        'sgu_w': nrm(ks[5], (L, SGU_GROUPS, SGU_CHUNK, SGU_CHUNK), 0.5 * SGU_CHUNK ** -0.5),
        'sgu_b': 1.0 + nrm(ks[6], (L, SGU_GROUPS, SGU_CHUNK), 0.1),
        'w_sgu_proj': nrm(ks[7], (L, SGU_WIDTH, D_MODEL), SGU_WIDTH ** -0.5),
        'w_gate': nrm(ks[8], (L, D_MODEL, N_BRANCHES * D_MODEL), D_MODEL ** -0.5),
        'b_gate': nrm(ks[9], (L, N_BRANCHES * D_MODEL), 0.1),
        'w_o': nrm(ks[10], (L, D_MODEL, D_MODEL), D_MODEL ** -0.5),
        'norm_ffn_g': 1.0 + nrm(ks[11], (L, D_MODEL), 0.01),
        'peer_wq': nrm(ks[12], (L, D_MODEL, PEER_HEADS * 2 * PEER_KEY_HALF), D_MODEL ** -0.5),
        'peer_subkeys': nrm(ks[13], (L, PEER_HEADS, 2, PEER_N_KEYS, PEER_KEY_HALF), PEER_KEY_HALF ** -0.5),
        'peer_u': nrm(ks[14], (L, PEER_N_EXPERTS, D_MODEL), D_MODEL ** -0.5),
        'peer_v': nrm(ks[15], (L, PEER_N_EXPERTS, D_MODEL), 0.5),
        'norm_final_g': 1.0 + nrm(ks[16], (D_MODEL,), 0.01),
    }


def reference(x, norm_mix_g, w_in, w_attn_proj, sgu_norm_g, sgu_w, sgu_b, w_sgu_proj,
              w_gate, b_gate, w_o, norm_ffn_g, peer_wq, peer_subkeys, peer_u, peer_v,
              norm_final_g):
    B, S, _ = x.shape
    cos, sin = rope_tables(S)
    splits = [ATTN_WIDTH, 2 * ATTN_WIDTH, 3 * ATTN_WIDTH, 3 * ATTN_WIDTH + SGU_WIDTH]
    for l in range(DEPTH):
        h = rms_norm(x, norm_mix_g[l])
        zq, zk, zva, zu, zv = jnp.split(h @ w_in[l], splits, axis=-1)
        q = apply_rope(zq.reshape(B, S, ATTN_HEADS, HEAD_DIM), cos, sin)
        k = apply_rope(zk.reshape(B, S, ATTN_HEADS, HEAD_DIM), cos, sin)
        va = zva.reshape(B, S, ATTN_HEADS, HEAD_DIM)
        y_attn = moba_attention(q, k, va) @ w_attn_proj[l]
        y_sgu = spatial_gating(zu, zv, sgu_norm_g[l], sgu_w[l], sgu_b[l]) @ w_sgu_proj[l]
        g_attn, g_sgu = jnp.split(jax.nn.sigmoid(h @ w_gate[l] + b_gate[l]), N_BRANCHES, axis=-1)
        x = x + (g_attn * y_attn + g_sgu * y_sgu) @ w_o[l]
        h2 = rms_norm(x, norm_ffn_g[l])
        x = x + peer_ffn(h2, peer_wq[l], peer_subkeys[l], peer_u[l], peer_v[l])
    return rms_norm(x, norm_final_g)
```

```cpp
#include <hip/hip_runtime.h>
#include <cstdio>
#include <cstdint>
namespace pg8 {
#define PG8_LAS __attribute__((address_space(3)))
typedef unsigned short bf16_t;
typedef short bf16x8 __attribute__((ext_vector_type(8)));
typedef float f32x4 __attribute__((ext_vector_type(4)));
typedef unsigned u32x4 __attribute__((ext_vector_type(4)));
constexpr int BM = 256, BK = 64, HALF = 128, HTB = HALF * BK * 2  , STAGE_BYTES = 8 * HTB, NXCD = 8, WGM = 8;

__host__ __device__ __forceinline__ int lds_byte(int r, int c) { const int st = (r >> 4) * 2 + (c >> 5), rr = r & 15, cc = c & 31, ob = rr * 64 + cc * 2; return st * 1024 + (ob ^ (((ob >> 9) & 1) << 5)); }
__host__ __device__ __forceinline__ void stage_rc(int b, int& R, int& C) { const int st = b / 1024, sb = b % 1024, swz = sb ^ (((sb >> 9) & 1) << 5); R = (st >> 1) * 16 + swz / 64; C = (st & 1) * 32 + (swz % 64) / 2; }
__host__ __device__ __forceinline__ int perm32(int rho) { const int n = rho >> 4, i = rho & 15; return 8 * (i >> 2) + 4 * n + (i & 3); }

struct Unit { int pm, pn; };
struct Gemm { const bf16_t* A; const bf16_t* Bt; int M, N, K; };

struct StaticOrder {
    int nM, nN, nwg, G, c;
    __host__ __device__ void init(int M, int N, int G_, int c_) { nM = M / BM; nN = N / BM; nwg = nM * nN; G = G_; c = c_; }
    __host__ __device__ bool next(int i, Unit& u) const {
        const long L = (long)i * G + c; if (L >= nwg) return false;
        int wgid = (int)L; { const int q = nwg / NXCD, r = nwg % NXCD, xcd = wgid % NXCD, off = wgid / NXCD; wgid = (xcd < r ? xcd * (q + 1) : r * (q + 1) + (xcd - r) * q) + off; }
        const int nig = WGM * nN, gid = wgid / nig, fm = gid * WGM, gsz = (nM - fm) < WGM ? (nM - fm) : WGM;
        u.pm = fm + ((wgid % nig) % gsz); u.pn = (wgid % nig) / gsz; return true;
    }
    __device__ __forceinline__ void a_ready(const Unit&) const {}
    __device__ __forceinline__ void done(const Unit&) const {}
};
typedef float f32x2 __attribute__((ext_vector_type(2)));
typedef __bf16 pg8_bf16x2 __attribute__((ext_vector_type(2)));
typedef _Float16 pg8_h2 __attribute__((ext_vector_type(2)));
__device__ __forceinline__ unsigned cvt_pk_bf16(float lo, float hi) { const f32x2 v = {lo, hi}; const pg8_bf16x2 r = __builtin_convertvector(v, pg8_bf16x2); return __builtin_bit_cast(unsigned, r); }

#define PG8_EPI_WAIT() asm volatile("s_waitcnt vmcnt(0)" ::: "memory")
#define PG8_PIN(v) asm volatile("s_waitcnt vmcnt(0)" : "+v"(v) : : "memory")
typedef unsigned u32x2 __attribute__((ext_vector_type(2)));
__device__ __forceinline__ unsigned pg8_pk4_fp8(f32x4 a) { int w = 0;
    w = __builtin_amdgcn_cvt_pk_fp8_f32(fminf(fmaxf(a[0], -448.f), 448.f), fminf(fmaxf(a[1], -448.f), 448.f), w, false); w = __builtin_amdgcn_cvt_pk_fp8_f32(fminf(fmaxf(a[2], -448.f), 448.f), fminf(fmaxf(a[3], -448.f), 448.f), w, true); return (unsigned)w; }
__device__ __forceinline__ float gelu_tanh(float x) {
    const float u = x * (0.7978845608f + 0.0356774081f * x * x);
    const float e = __builtin_amdgcn_exp2f(u * -2.8853900818f);
    return x * __builtin_amdgcn_rcpf(1.0f + e);
}
__device__ __forceinline__ float sigm(float z) { return __builtin_amdgcn_rcpf(1.0f + __builtin_amdgcn_exp2f(z * -1.4426950409f)); }
__device__ __forceinline__ float bf_lo(unsigned w) { return __uint_as_float(w << 16); }
__device__ __forceinline__ float bf_hi(unsigned w) { return __uint_as_float(w & 0xffff0000u); }

struct EpiIn {
    static constexpr bool PERM = true, AFTER_DRAIN = false;
    const float* ss1; const float* cosT; const float* sinT; const float* bgate; float* kacc;
    int mode; float descale;
    bf16_t *QKVUG, *G;
    __device__ __forceinline__ void operator()(const f32x4 (&acc)[2][2][4][2], const Unit& u, int wr, int wc, int fr, int fq) const {
        asm volatile("" : "+v"(fr), "+v"(fq));
        const int colt = mode == 2 ? u.pn * BM : (mode == 0 ? 6144 + u.pn * BM : (u.pn < 24 ? u.pn * BM : 10240 + (u.pn - 24) * BM)), reg = colt >> 11;
        const int row0 = u.pm * BM + wr * 64 + fr, cw = wc * 32 + 8 * fq;
        float rs[2][4];
#pragma unroll
        for (int ai = 0; ai < 2; ++ai)
#pragma unroll
            for (int m = 0; m < 4; ++m) rs[ai][m] = ss1[row0 + ai * HALF + m * 16];
#define PG8_RS_READY() do { PG8_EPI_WAIT(); _Pragma("unroll") for (int ai = 0; ai < 2; ++ai) _Pragma("unroll") for (int m = 0; m < 4; ++m) { PG8_PIN(rs[ai][m]); rs[ai][m] = rsqrtf(rs[ai][m] * (1.0f / 4096.0f) + 1e-6f) * descale; } } while (0)
        if (reg <= 1) {
            bf16_t* dst = QKVUG + (size_t)reg * ((size_t)16384 * 2048); const int colh = colt - reg * 2048, g4 = (wc * 4 + fq) * 4;
            f32x4 ks[2][2];
#pragma unroll
            for (int bj = 0; bj < 2; ++bj) { ks[bj][0] = (f32x4){0.f, 0.f, 0.f, 0.f}; ks[bj][1] = (f32x4){0.f, 0.f, 0.f, 0.f}; }
#pragma unroll
            for (int ai = 0; ai < 2; ++ai) {
                f32x4 cc[4], sn[4];
#pragma unroll
                for (int mm = 0; mm < 4; ++mm) { const int row = row0 + ai * HALF + mm * 16; cc[mm] = *(const f32x4*)(cosT + (size_t)row * 64 + g4); sn[mm] = *(const f32x4*)(sinT + (size_t)row * 64 + g4); }
                if (ai == 0) PG8_RS_READY(); else PG8_EPI_WAIT();
#pragma unroll
                for (int mm = 0; mm < 4; ++mm) { PG8_PIN(cc[mm]); PG8_PIN(sn[mm]); }
#pragma unroll
                for (int m2 = 0; m2 < 4; m2 += 2)
#pragma unroll
                    for (int bj = 0; bj < 2; ++bj) { u32x2 wa, wb;
#pragma unroll
                        for (int mq = 0; mq < 2; ++mq) { const int m = m2 + mq; const float r = rs[ai][m]; const f32x4 c4 = cc[m], s4 = sn[m];
                            const f32x4 x1 = acc[ai][bj][m][0] * r, x2 = acc[ai][bj][m][1] * r;
                            const f32x4 o1 = x1 * c4 - x2 * s4, o2 = x2 * c4 + x1 * s4;
                            u32x2 w; w.x = pg8_pk4_fp8(o1 * 8.0f); w.y = pg8_pk4_fp8(o2 * 8.0f); if (mq == 0) wa = w; else wb = w;
                            ks[bj][0] += o1; ks[bj][1] += o2; }
                        { const auto s0 = __builtin_amdgcn_permlane16_swap(wa.x, wb.x, false, false); wa.x = s0[0]; wb.x = s0[1]; }
                        { const auto s1 = __builtin_amdgcn_permlane16_swap(wa.y, wb.y, false, false); wa.y = s1[0]; wb.y = s1[1]; }
                        const int row = row0 + ai * HALF + (m2 + (fq & 1)) * 16;
                        *(u32x4*)((unsigned char*)dst + (size_t)row * 2048 + colh + bj * HALF + cw - 8 * (fq & 1)) = (u32x4){wa.x, wa.y, wb.x, wb.y}; } }
            if (reg == 1) { PG8_EPI_WAIT();
#pragma unroll
                for (int bj = 0; bj < 2; ++bj)
#pragma unroll
                    for (int n = 0; n < 2; ++n)
#pragma unroll
                        for (int e = 0; e < 4; ++e) { float v = ks[bj][n][e];
                            v += __shfl_xor(v, 1); v += __shfl_xor(v, 2); v += __shfl_xor(v, 4); v += __shfl_xor(v, 8);
                            if (fr == 0) atomicAdd(kacc + ((size_t)((colh >> 7) + bj) * 64 + u.pm) * 128 + cw + 4 * n + e, v); }
            }
        } else if (reg <= 4) {
            bf16_t* dst = QKVUG + (size_t)reg * ((size_t)16384 * 2048); const int colh = colt - reg * 2048;
            PG8_RS_READY();
            if (reg == 2) {
#pragma unroll
              for (int ai = 0; ai < 2; ++ai)
#pragma unroll
                for (int m2 = 0; m2 < 4; m2 += 2)
#pragma unroll
                    for (int bj = 0; bj < 2; ++bj) { u32x2 wa, wb;
                        wa.x = pg8_pk4_fp8(acc[ai][bj][m2][0] * (rs[ai][m2] * 8.0f)); wa.y = pg8_pk4_fp8(acc[ai][bj][m2][1] * (rs[ai][m2] * 8.0f));
                        wb.x = pg8_pk4_fp8(acc[ai][bj][m2 + 1][0] * (rs[ai][m2 + 1] * 8.0f)); wb.y = pg8_pk4_fp8(acc[ai][bj][m2 + 1][1] * (rs[ai][m2 + 1] * 8.0f));
                        { const auto s0 = __builtin_amdgcn_permlane16_swap(wa.x, wb.x, false, false); wa.x = s0[0]; wb.x = s0[1]; }
                        { const auto s1 = __builtin_amdgcn_permlane16_swap(wa.y, wb.y, false, false); wa.y = s1[0]; wb.y = s1[1]; }
                        const int row = row0 + ai * HALF + (m2 + (fq & 1)) * 16;
                        *(u32x4*)((unsigned char*)dst + (size_t)row * 2048 + colh + bj * HALF + cw - 8 * (fq & 1)) = (u32x4){wa.x, wa.y, wb.x, wb.y}; }
            } else {
#pragma unroll
              for (int ai = 0; ai < 2; ++ai)
#pragma unroll
                for (int m = 0; m < 4; ++m) { const int row = row0 + ai * HALF + m * 16; const float r = rs[ai][m];
#pragma unroll
                    for (int bj = 0; bj < 2; ++bj) { f32x4 v0 = acc[ai][bj][m][0] * r, v1 = acc[ai][bj][m][1] * r;
#pragma unroll
                        for (int e = 0; e < 4; ++e) { v0[e] = gelu_tanh(v0[e]); v1[e] = gelu_tanh(v1[e]); }
                        u32x4 w; w.x = cvt_pk_bf16(v0[0], v0[1]); w.y = cvt_pk_bf16(v0[2], v0[3]); w.z = cvt_pk_bf16(v1[0], v1[1]); w.w = cvt_pk_bf16(v1[2], v1[3]);
                        *(u32x4*)(dst + (size_t)row * 2048 + colh + bj * HALF + cw) = w; } }
            }
        } else {
            const int gcol = colt - 10240 + cw;
            f32x4 bv[2][2];
#pragma unroll
            for (int bj = 0; bj < 2; ++bj) { bv[bj][0] = *(const f32x4*)(bgate + gcol + bj * HALF); bv[bj][1] = *(const f32x4*)(bgate + gcol + bj * HALF + 4); }
            PG8_RS_READY();
#pragma unroll
            for (int bj = 0; bj < 2; ++bj) { PG8_PIN(bv[bj][0]); PG8_PIN(bv[bj][1]); }
            const int odd = fq & 1;
#pragma unroll
            for (int ai = 0; ai < 2; ++ai)
#pragma unroll
                for (int m = 0; m < 4; m += 2)
#pragma unroll
                    for (int bj = 0; bj < 2; ++bj) { u32x2 wa, wb;
#pragma unroll
                        for (int mm = 0; mm < 2; ++mm) { const float r = rs[ai][m + mm]; f32x4 v0 = acc[ai][bj][m + mm][0] * r + bv[bj][0], v1 = acc[ai][bj][m + mm][1] * r + bv[bj][1];
#pragma unroll
                            for (int e = 0; e < 4; ++e) { v0[e] = sigm(v0[e]); v1[e] = sigm(v1[e]); }
                            u32x2 w; w.x = pg8_pk4_fp8((v0 - 0.5f) * 256.0f); w.y = pg8_pk4_fp8((v1 - 0.5f) * 256.0f); if (mm == 0) wa = w; else wb = w; }
                        { const auto s0 = __builtin_amdgcn_permlane16_swap(wa.x, wb.x, false, false); wa.x = s0[0]; wb.x = s0[1]; }
                        { const auto s1 = __builtin_amdgcn_permlane16_swap(wa.y, wb.y, false, false); wa.y = s1[0]; wb.y = s1[1]; }
                        const int row = row0 + ai * HALF + (m + odd) * 16;
                        *(u32x4*)((unsigned char*)G + (size_t)row * 8192 + gcol - 8 * odd + bj * HALF) = (u32x4){wa.x, wa.y, wb.x, wb.y}; }
        }
    }
};
template <int SECOND> struct EpiMix {
    static constexpr bool PERM = true, AFTER_DRAIN = false;
    const bf16_t* G; bf16_t* MIX; bf16_t* TMP; float descale; float smix;
    __device__ __forceinline__ void operator()(const f32x4 (&acc)[2][2][4][2], const Unit& u, int wr, int wc, int fr, int fq) const {
        asm volatile("" : "+v"(fr), "+v"(fq));
        const int row0 = u.pm * BM + wr * 64 + fr, col0 = u.pn * BM + wc * 32 + 8 * fq;
#pragma unroll
        for (int ai = 0; ai < 2; ++ai) {
            u32x2 wout[4][2];
            u32x2 gv[4][2], pv[4][2];
#pragma unroll
            for (int m = 0; m < 4; ++m)
#pragma unroll
                for (int bj = 0; bj < 2; ++bj) { const size_t row = (size_t)(row0 + ai * HALF + m * 16); const int col = col0 + bj * HALF;
                    gv[m][bj] = *(const u32x2*)((const unsigned char*)G + row * 8192 + SECOND * 4096 + col);
                    if (SECOND) pv[m][bj] = *(const u32x2*)((const unsigned char*)TMP + row * 4096 + col); }
            PG8_EPI_WAIT();
#pragma unroll
            for (int m = 0; m < 4; ++m)
#pragma unroll
                for (int bj = 0; bj < 2; ++bj) { PG8_PIN(gv[m][bj]); if (SECOND) PG8_PIN(pv[m][bj]); }
#pragma unroll
            for (int m = 0; m < 4; ++m)
#pragma unroll
                for (int bj = 0; bj < 2; ++bj) { const size_t row = (size_t)(row0 + ai * HALF + m * 16); const int col = col0 + bj * HALF;
                    const u32x2 g = gv[m][bj];
                    f32x4 v0 = acc[ai][bj][m][0] * descale, v1 = acc[ai][bj][m][1] * descale;
                    { const f32x2 g0 = __builtin_amdgcn_cvt_pk_f32_fp8((int)g.x, false), g1 = __builtin_amdgcn_cvt_pk_f32_fp8((int)g.x, true), g2 = __builtin_amdgcn_cvt_pk_f32_fp8((int)g.y, false), g3 = __builtin_amdgcn_cvt_pk_f32_fp8((int)g.y, true);
                      constexpr float GI = 1.0f / 256.0f;
                      v0[0] *= g0.x * GI + 0.5f; v0[1] *= g0.y * GI + 0.5f; v0[2] *= g1.x * GI + 0.5f; v0[3] *= g1.y * GI + 0.5f; v1[0] *= g2.x * GI + 0.5f; v1[1] *= g2.y * GI + 0.5f; v1[2] *= g3.x * GI + 0.5f; v1[3] *= g3.y * GI + 0.5f; }
#if defined(PROBE_NO_ATTN)
                    if (!SECOND) { v0 = v0 * 0.f; v1 = v1 * 0.f; }
#endif
                    if (SECOND) { const u32x2 p = pv[m][bj];
                        const f32x2 p0 = __builtin_amdgcn_cvt_pk_f32_fp8((int)p.x, false), p1 = __builtin_amdgcn_cvt_pk_f32_fp8((int)p.x, true), p2 = __builtin_amdgcn_cvt_pk_f32_fp8((int)p.y, false), p3 = __builtin_amdgcn_cvt_pk_f32_fp8((int)p.y, true);
                        v0[0] += p0.x * (1.0f / 64.0f); v0[1] += p0.y * (1.0f / 64.0f); v0[2] += p1.x * (1.0f / 64.0f); v0[3] += p1.y * (1.0f / 64.0f);
                        v1[0] += p2.x * (1.0f / 64.0f); v1[1] += p2.y * (1.0f / 64.0f); v1[2] += p3.x * (1.0f / 64.0f); v1[3] += p3.y * (1.0f / 64.0f); }
                    (void)row; (void)col;
                    if (SECOND) { wout[m][bj].x = pg8_pk4_fp8(v0 * smix); wout[m][bj].y = pg8_pk4_fp8(v1 * smix); }
                    else { wout[m][bj].x = pg8_pk4_fp8(v0 * 64.0f); wout[m][bj].y = pg8_pk4_fp8(v1 * 64.0f); } }
#pragma unroll
            for (int m = 0; m < 4; m += 2)
#pragma unroll
                for (int bj = 0; bj < 2; ++bj) { u32x2 wa = wout[m][bj], wb = wout[m + 1][bj];
                    { const auto s0 = __builtin_amdgcn_permlane16_swap(wa.x, wb.x, false, false); wa.x = s0[0]; wb.x = s0[1]; }
                    { const auto s1 = __builtin_amdgcn_permlane16_swap(wa.y, wb.y, false, false); wa.y = s1[0]; wb.y = s1[1]; }
                    const size_t row = (size_t)(row0 + ai * HALF + (m + (fq & 1)) * 16); const int col = col0 + bj * HALF - 8 * (fq & 1);
                    *(u32x4*)((unsigned char*)(SECOND ? MIX : TMP) + row * 4096 + col) = (u32x4){wa.x, wa.y, wb.x, wb.y}; }
        }
    }
};
struct EpiWo {
    static constexpr bool PERM = true, AFTER_DRAIN = false;
    const float* x; float* x1; bf16_t* x1b; float* ss2; float descale;
    __device__ __forceinline__ void operator()(const f32x4 (&acc)[2][2][4][2], const Unit& u, int wr, int wc, int fr, int fq) const {
        asm volatile("" : "+v"(fr), "+v"(fq));
        const int row0 = u.pm * BM + wr * 64 + fr, col0 = u.pn * BM + wc * 32 + 8 * fq;
        const unsigned short* xb = (const unsigned short*)x;
        u32x4 xr[2][4][2];
#pragma unroll
        for (int ai = 0; ai < 2; ++ai)
#pragma unroll
            for (int mm = 0; mm < 4; ++mm)
#pragma unroll
                for (int bj = 0; bj < 2; ++bj) xr[ai][mm][bj] = *(const u32x4*)(xb + (size_t)(row0 + ai * HALF + mm * 16) * 4096 + col0 + bj * HALF);
        PG8_EPI_WAIT();
#pragma unroll
        for (int ai = 0; ai < 2; ++ai)
#pragma unroll
            for (int mm = 0; mm < 4; ++mm)
#pragma unroll
                for (int bj = 0; bj < 2; ++bj) PG8_PIN(xr[ai][mm][bj]);
#pragma unroll
        for (int ai = 0; ai < 2; ++ai) {
#pragma unroll
                for (int mm = 0; mm < 4; ++mm) { const int m = mm; const int row = row0 + ai * HALF + m * 16; float sq = 0.f;
#pragma unroll
                    for (int bj = 0; bj < 2; ++bj) { const size_t o = (size_t)row * 4096 + col0 + bj * HALF; const u32x4 xw = xr[ai][mm][bj];
                        const f32x4 xa = {__uint_as_float(xw.x << 16), __uint_as_float(xw.x & 0xffff0000u), __uint_as_float(xw.y << 16), __uint_as_float(xw.y & 0xffff0000u)};
                        const f32x4 xc = {__uint_as_float(xw.z << 16), __uint_as_float(xw.z & 0xffff0000u), __uint_as_float(xw.w << 16), __uint_as_float(xw.w & 0xffff0000u)};
                        const f32x4 v0 = xa + acc[ai][bj][m][0] * descale, v1 = xc + acc[ai][bj][m][1] * descale;
                        u32x4 w; w.x = cvt_pk_bf16(v0[0], v0[1]); w.y = cvt_pk_bf16(v0[2], v0[3]); w.z = cvt_pk_bf16(v1[0], v1[1]); w.w = cvt_pk_bf16(v1[2], v1[3]);
                        *(u32x4*)(x1b + o) = w;
                        sq += (v0[0] * v0[0] + v0[1] * v0[1]) + (v0[2] * v0[2] + v0[3] * v0[3]) + (v1[0] * v1[0] + v1[1] * v1[1]) + (v1[2] * v1[2] + v1[3] * v1[3]); }
                    sq += __shfl_xor(sq, 16); sq += __shfl_xor(sq, 32);
                    if (fq == 0) ss2[(size_t)row * 64 + u.pn * 4 + wc] = sq; }
            }
    }
};
struct EpiNull {
    static constexpr bool PERM = true, AFTER_DRAIN = false;
    __device__ __forceinline__ void operator()(const f32x4 (&acc)[2][2][4][2], const Unit& u, int wr, int wc, int fr, int fq) const {
#pragma unroll
        for (int ai = 0; ai < 2; ++ai)
#pragma unroll
            for (int bj = 0; bj < 2; ++bj)
#pragma unroll
                for (int m = 0; m < 4; ++m) { asm volatile("" :: "v"(acc[ai][bj][m][0]), "v"(acc[ai][bj][m][1])); } }
};
struct EpiS {
    static constexpr bool PERM = true, AFTER_DRAIN = false;
    float* S;
    __device__ __forceinline__ void operator()(const f32x4 (&acc)[2][2][4][2], const Unit& u, int wr, int wc, int fr, int fq) const {
        asm volatile("" : "+v"(fr), "+v"(fq));
        const int row0 = u.pm * BM + wr * 64 + fr, col0 = u.pn * BM + wc * 32 + 8 * fq;
#pragma unroll
        for (int ai = 0; ai < 2; ++ai)
#pragma unroll
            for (int m = 0; m < 4; ++m) { const int row = row0 + ai * HALF + m * 16;
#pragma unroll
                for (int bj = 0; bj < 2; ++bj) {
                    typedef _Float16 h2_t __attribute__((ext_vector_type(2)));
                    const f32x4 a0 = acc[ai][bj][m][0], a1 = acc[ai][bj][m][1];
                    u32x4 w; w.x = __builtin_bit_cast(unsigned, __builtin_amdgcn_cvt_pkrtz(a0[0], a0[1])); w.y = __builtin_bit_cast(unsigned, __builtin_amdgcn_cvt_pkrtz(a0[2], a0[3]));
                    w.z = __builtin_bit_cast(unsigned, __builtin_amdgcn_cvt_pkrtz(a1[0], a1[1])); w.w = __builtin_bit_cast(unsigned, __builtin_amdgcn_cvt_pkrtz(a1[2], a1[3]));
                    *(u32x4*)((unsigned short*)S + (size_t)row * 2048 + col0 + bj * HALF) = w; } }
    }
};
typedef int i32x8 __attribute__((ext_vector_type(8)));
typedef int i32x4 __attribute__((ext_vector_type(4)));
__device__ __forceinline__ i32x8 pg8_cat(bf16x8 lo, bf16x8 hi) { const i32x4 a = __builtin_bit_cast(i32x4, lo), b = __builtin_bit_cast(i32x4, hi); return __builtin_shufflevector(a, b, 0, 1, 2, 3, 4, 5, 6, 7); }
template <class Epi, class Sched, bool ALIGN_EPI = false, bool SP2 = false, bool F8 = false>
__device__ __forceinline__ void gemm_phase(PG8_LAS unsigned char* lds, const Gemm g, const Sched& S, const Epi& E) {
    const int tid = threadIdx.x, wid = __builtin_amdgcn_readfirstlane(tid >> 6), lane = tid & 63, wr = wid >> 2, wc = wid & 3, fr = lane & 15, fq = lane >> 4;
    constexpr int ESZ = F8 ? 1 : 2;
    const int K = g.K, nt = (K * ESZ) / 128;
    unsigned voffA[2], voffB[2];
#pragma unroll
    for (int i = 0; i < 2; ++i) { int R, C; stage_rc(tid * 16 + i * 8192, R, C); const int Rb = Epi::PERM ? ((R & ~31) + perm32(R & 31)) : R;
        voffA[i] = (unsigned)(R * K * ESZ + C * 2); voffB[i] = (unsigned)(Rb * K * ESZ + C * 2); }
    const size_t kstep = (size_t)(BK * 2);
    const size_t hstep = (size_t)HALF * K * ESZ;
    const size_t tstep = 2 * hstep;
    const unsigned ldsw = (unsigned)wid * 1024u;
    const int aoff0 = lds_byte(wr * 64 + fr, fq * 8), aoff1 = aoff0 + 1024;
    const int boff0 = lds_byte(wc * 32 + fr, fq * 8), boff1 = boff0 + 1024;
#define PG8_SA(b, h) (((b) * 2 + (h)) * HTB)
#define PG8_SB(b, h) ((4 + (b) * 2 + (h)) * HTB)
#define PG8_STAGE(bufoff, gbase, voff) do { _Pragma("unroll") for (int _i = 0; _i < 2; ++_i) \
        __builtin_amdgcn_global_load_lds((const unsigned*)((const char*)(gbase) + (voff)[_i]), (PG8_LAS unsigned*)(lds + (bufoff) + ldsw + _i * 8192), 16, 0, 0); } while (0)
#define PG8_LDA(dst, b, h) do { if constexpr (F8) { _Pragma("unroll") for (int m = 0; m < 4; ++m) dst##8[m] = pg8_cat(*(const PG8_LAS bf16x8*)(lds + PG8_SA(b, h) + aoff0 + m * 2048), *(const PG8_LAS bf16x8*)(lds + PG8_SA(b, h) + aoff1 + m * 2048)); }     \
    else { _Pragma("unroll") for (int m = 0; m < 4; ++m) _Pragma("unroll") for (int k = 0; k < 2; ++k) dst[m][k] = *(const PG8_LAS bf16x8*)(lds + PG8_SA(b, h) + (k ? aoff1 : aoff0) + m * 2048); } } while (0)
#define PG8_LDB(dst, b, h) do { if constexpr (F8) { _Pragma("unroll") for (int n = 0; n < 2; ++n) dst##8[n] = pg8_cat(*(const PG8_LAS bf16x8*)(lds + PG8_SB(b, h) + boff0 + n * 2048), *(const PG8_LAS bf16x8*)(lds + PG8_SB(b, h) + boff1 + n * 2048)); } \
    else { _Pragma("unroll") for (int n = 0; n < 2; ++n) _Pragma("unroll") for (int k = 0; k < 2; ++k) dst[n][k] = *(const PG8_LAS bf16x8*)(lds + PG8_SB(b, h) + (k ? boff1 : boff0) + n * 2048); } } while (0)
#define PG8_MMA(ai, bj, At, Bt) do { __builtin_amdgcn_s_setprio(1); _Pragma("unroll") for (int m = 0; m < 4; ++m) _Pragma("unroll") for (int n = 0; n < 2; ++n) { \
        if constexpr (F8) asm volatile("v_mfma_scale_f32_16x16x128_f8f6f4 %0, %1, %2, %0, %3, %3 op_sel_hi:[0,0,0]" : "+v"(acc[ai][bj][m][n]) : "v"(Bt##8[n]), "v"(At##8[m]), "v"(mxs));   \
        else { _Pragma("unroll") for (int k = 0; k < 2; ++k) acc[ai][bj][m][n] = __builtin_amdgcn_mfma_f32_16x16x32_bf16(Bt[n][k], At[m][k], acc[ai][bj][m][n], 0, 0, 0); } } __builtin_amdgcn_s_setprio(0); } while (0)
#define PG8_WAIT_V(n) asm volatile("s_waitcnt vmcnt(" #n ")" ::: "memory")
#define PG8_WAIT_L(n) asm volatile("s_waitcnt lgkmcnt(" #n ")" ::: "memory")
#define PG8_BAR __builtin_amdgcn_s_barrier()
#define PG8_SCHED __builtin_amdgcn_sched_barrier(0)
    Unit cur, nxt; int ui = 0;
    if (!S.next(0, cur)) return;
    f32x4 acc[2][2][4][2];
#pragma unroll
    for (int a = 0; a < 2; ++a)
#pragma unroll
        for (int b = 0; b < 2; ++b)
#pragma unroll
            for (int m = 0; m < 4; ++m)
#pragma unroll
                for (int n = 0; n < 2; ++n) acc[a][b][m][n] = (f32x4){0.f, 0.f, 0.f, 0.f};
    int mxs = 0x7f7f7f7f; asm volatile("" : "+v"(mxs));
    bf16x8 At[4][2], B0[2][2], B1[2][2];
    i32x8 At8[4], B08[2], B18[2];
    const char* cA = (const char*)g.A + (size_t)cur.pm * tstep; const char* cB = (const char*)g.Bt + (size_t)cur.pn * tstep;
    S.a_ready(cur);
    if constexpr (SP2) {
        PG8_STAGE(PG8_SB(0, 0), cB, voffB); PG8_STAGE(PG8_SB(0, 1), cB + hstep, voffB); PG8_STAGE(PG8_SA(0, 0), cA, voffA); PG8_STAGE(PG8_SA(0, 1), cA + hstep, voffA);
        if (wr == 1) PG8_BAR;
        PG8_WAIT_V(2); PG8_BAR;
        PG8_STAGE(PG8_SB(1, 0), cB + kstep, voffB); PG8_STAGE(PG8_SA(1, 0), cA + kstep, voffA); PG8_STAGE(PG8_SB(1, 1), cB + hstep + kstep, voffB);
        PG8_WAIT_V(6); PG8_BAR;
    } else {
        PG8_STAGE(PG8_SB(0, 0), cB, voffB); PG8_STAGE(PG8_SA(0, 0), cA, voffA); PG8_STAGE(PG8_SB(0, 1), cB + hstep, voffB); PG8_STAGE(PG8_SA(0, 1), cA + hstep, voffA);
        if (wr == 1) PG8_BAR;
        PG8_WAIT_V(4); PG8_BAR;
        PG8_STAGE(PG8_SB(1, 0), cB + kstep, voffB); PG8_STAGE(PG8_SA(1, 0), cA + kstep, voffA); PG8_STAGE(PG8_SB(1, 1), cB + hstep + kstep, voffB);
        PG8_WAIT_V(6); PG8_BAR;
    }
    for (;;) {
        const bool has_next = S.next(ui + 1, nxt);
        const char* nA = has_next ? (const char*)g.A + (size_t)nxt.pm * tstep : cA; const char* nB = has_next ? (const char*)g.Bt + (size_t)nxt.pn * tstep : cB;
        for (int t = 0; t < nt; t += 2) {
            const bool last = (t == nt - 2);
            const char* a1 = cA + (size_t)(t + 1) * kstep;
            const char* a2 = last ? nA : cA + (size_t)(t + 2) * kstep; const char* b2 = last ? nB : cB + (size_t)(t + 2) * kstep;
            const char* a3 = a2 + kstep; const char* b3 = b2 + kstep;
            if (last && has_next) S.a_ready(nxt);
            if constexpr (SP2) {
            PG8_LDB(B0, 0, 0); PG8_LDB(B1, 0, 1); PG8_SCHED; PG8_LDA(At, 0, 0); PG8_STAGE(PG8_SA(1, 1), a1 + hstep, voffA);
            PG8_WAIT_V(8); PG8_WAIT_L(0); PG8_BAR; PG8_MMA(0, 0, At, B0); PG8_MMA(0, 1, At, B1); PG8_BAR; PG8_SCHED;
            PG8_LDA(At, 0, 1); PG8_STAGE(PG8_SB(0, 0), b2, voffB); PG8_STAGE(PG8_SB(0, 1), b2 + hstep, voffB); PG8_STAGE(PG8_SA(0, 0), a2, voffA);
            PG8_WAIT_V(8); PG8_WAIT_L(0); PG8_BAR; PG8_MMA(1, 0, At, B0); PG8_MMA(1, 1, At, B1); PG8_BAR; PG8_SCHED;
            PG8_LDB(B0, 1, 0); PG8_LDB(B1, 1, 1); PG8_SCHED; PG8_LDA(At, 1, 0); PG8_STAGE(PG8_SA(0, 1), a2 + hstep, voffA);
            PG8_WAIT_V(8); PG8_WAIT_L(0); PG8_BAR; PG8_MMA(0, 0, At, B0); PG8_MMA(0, 1, At, B1); PG8_BAR; PG8_SCHED;
            PG8_LDA(At, 1, 1); PG8_STAGE(PG8_SB(1, 0), b3, voffB); PG8_STAGE(PG8_SB(1, 1), b3 + hstep, voffB); PG8_STAGE(PG8_SA(1, 0), a3, voffA);
            PG8_WAIT_V(8); PG8_WAIT_L(0); PG8_BAR; PG8_MMA(1, 0, At, B0); PG8_MMA(1, 1, At, B1); PG8_BAR; PG8_SCHED;
            } else {
            PG8_LDB(B0, 0, 0); PG8_SCHED; PG8_LDA(At, 0, 0); PG8_STAGE(PG8_SA(1, 1), a1 + hstep, voffA);
            PG8_WAIT_L(8); PG8_BAR; PG8_WAIT_L(0); PG8_MMA(0, 0, At, B0); PG8_BAR; PG8_SCHED;
            PG8_LDB(B1, 0, 1); PG8_STAGE(PG8_SB(0, 0), b2, voffB);
            PG8_BAR; PG8_WAIT_L(0); PG8_MMA(0, 1, At, B1); PG8_BAR;
            PG8_LDA(At, 0, 1); PG8_STAGE(PG8_SA(0, 0), a2, voffA);
            PG8_BAR; PG8_WAIT_L(0); PG8_MMA(1, 0, At, B0); PG8_BAR; PG8_SCHED;
            PG8_STAGE(PG8_SB(0, 1), b2 + hstep, voffB);
            PG8_WAIT_V(6); PG8_BAR; PG8_MMA(1, 1, At, B1); PG8_BAR;
            PG8_LDB(B0, 1, 0); PG8_SCHED; PG8_LDA(At, 1, 0); PG8_STAGE(PG8_SA(0, 1), a2 + hstep, voffA);
            PG8_WAIT_L(8); PG8_BAR; PG8_WAIT_L(0); PG8_MMA(0, 0, At, B0); PG8_BAR; PG8_SCHED;
            PG8_LDB(B1, 1, 1); PG8_STAGE(PG8_SB(1, 0), b3, voffB);
            PG8_BAR; PG8_WAIT_L(0); PG8_MMA(0, 1, At, B1); PG8_BAR;
            PG8_LDA(At, 1, 1); PG8_STAGE(PG8_SA(1, 0), a3, voffA);
            PG8_BAR; PG8_WAIT_L(0); PG8_MMA(1, 0, At, B0); PG8_BAR; PG8_SCHED;
            PG8_STAGE(PG8_SB(1, 1), b3 + hstep, voffB);
            PG8_WAIT_V(6); PG8_BAR; PG8_MMA(1, 1, At, B1); PG8_BAR;
            }
        }
        if constexpr (ALIGN_EPI) { if (wr == 0) PG8_BAR; }
        if constexpr (!Epi::AFTER_DRAIN) { E(acc, cur, wr, wc, fr, fq); S.done(cur);
#if defined(PROBE_EPI_DRAIN)
            PG8_WAIT_V(0);
#endif
        }
        if (!has_next) break;
#pragma unroll
        for (int a = 0; a < 2; ++a)
#pragma unroll
            for (int b = 0; b < 2; ++b)
#pragma unroll
                for (int m = 0; m < 4; ++m)
#pragma unroll
                    for (int n = 0; n < 2; ++n) acc[a][b][m][n] = (f32x4){0.f, 0.f, 0.f, 0.f};
        cur = nxt; cA = nA; cB = nB; ++ui;
        if constexpr (ALIGN_EPI) { if (wr == 1) PG8_BAR; }
    }
    PG8_WAIT_V(0);
    if constexpr (!ALIGN_EPI) { if (wr == 0) PG8_BAR; }
    PG8_BAR;
    if constexpr (Epi::AFTER_DRAIN) { E.fused(acc, cur, wr, wc, fr, fq, lds, wid, lane); S.done(cur); }
#undef PG8_SA
#undef PG8_SB
#undef PG8_STAGE
#undef PG8_LDA
#undef PG8_LDB
#undef PG8_MMA
#undef PG8_WAIT_V
#undef PG8_WAIT_L
#undef PG8_BAR
#undef PG8_SCHED
}
}
#define LAS __attribute__((address_space(3)))
#define XB_TMO      128
#define XB_XCNT(j)  (256  + 64 * (j))
#define XB_XSUB(j)  (1280 + 64 * (j))
#define XB_XGEN(j)  (2304 + 64 * (j))
#define XB_TOP      3328
#define XB_TOPGEN   3392
#define XCD_BAR_WORDS 3456
#define XB_SPIN_CAP (1u << 24)

__device__ __forceinline__ unsigned xb_ld(unsigned* p)              { return __hip_atomic_load(p, __ATOMIC_RELAXED, __HIP_MEMORY_SCOPE_AGENT); }
__device__ __forceinline__ unsigned xb_add(unsigned* p, unsigned v) { return __hip_atomic_fetch_add(p, v, __ATOMIC_RELAXED, __HIP_MEMORY_SCOPE_AGENT); }
__device__ __forceinline__ unsigned xb_xcc_id() { return (unsigned)__builtin_amdgcn_s_getreg((3 << 11) | 20) & 0xFu; }
#define XB_SPIN(cond, bar) do { unsigned _sp = 0; while (cond) { __builtin_amdgcn_s_sleep(1); \
    if ((++_sp & 255u) == 0u) { if (xb_ld(&(bar)[XB_TMO])) break; if (_sp > XB_SPIN_CAP) { atomicAdd(&(bar)[XB_TMO], 1u); break; } } } } while (0)

struct XcdBarrier {
    unsigned* bar; unsigned x;
    volatile LAS unsigned* st;
};

__device__ __forceinline__ XcdBarrier xcd_barrier_post(unsigned* bar, volatile LAS unsigned* st) {
    XcdBarrier b; b.bar = bar; b.x = xb_xcc_id(); b.st = st;
    if (threadIdx.x == 0) (void)xb_add(&bar[XB_XCNT(b.x)], 1u);
    return b;
}
__device__ __forceinline__ void xcd_barrier_complete(unsigned* bar, unsigned x, unsigned& nloc, unsigned& nx) {
    const unsigned G = gridDim.x * gridDim.y * gridDim.z;
    unsigned sum, cnt, mine, sp = 0u;
    for (;;) {
        sum = 0u; cnt = 0u; mine = 0u;
#pragma unroll
        for (unsigned j = 0; j < 16; ++j) { const unsigned c = xb_ld(&bar[XB_XCNT(j)]); sum += c; cnt += (c > 0u) ? 1u : 0u; mine = (j == x) ? c : mine; }
        if (sum == G) break;
        __builtin_amdgcn_s_sleep(1);
        if ((++sp & 255u) == 0u) { if (xb_ld(&bar[XB_TMO])) break; if (sp > XB_SPIN_CAP) { atomicAdd(&bar[XB_TMO], 1u); break; } }
    }
    nloc = mine > 0u ? mine : 1u; nx = cnt > 0u ? cnt : 1u;
}

__device__ __forceinline__ void xcd_barrier(const XcdBarrier& b) {
    asm volatile("s_waitcnt vmcnt(0)" ::: "memory");
    __syncthreads();
    if (threadIdx.x == 0) {
        unsigned* bar = b.bar;
        __builtin_amdgcn_s_waitcnt(0);
        unsigned nloc = b.st[0], nx = b.st[1];
        if (nloc == 0u) { xcd_barrier_complete(bar, b.x, nloc, nx); b.st[0] = nloc; b.st[1] = nx; }
        const unsigned old = xb_add(&bar[XB_XSUB(b.x)], 1u);
        const unsigned gen = old / nloc;
        if (old + 1u == (gen + 1u) * nloc) {
            __builtin_amdgcn_fence(__ATOMIC_RELEASE, "agent");
            asm volatile("s_waitcnt vmcnt(0)" ::: "memory");
            const unsigned og = xb_add(&bar[XB_TOP], 1u);
            const unsigned tg = og / nx;
            if (og + 1u == (tg + 1u) * nx) xb_add(&bar[XB_TOPGEN], 1u);
            else XB_SPIN(xb_ld(&bar[XB_TOPGEN]) == tg, bar);
            __builtin_amdgcn_fence(__ATOMIC_ACQUIRE, "agent");
            xb_add(&bar[XB_XGEN(b.x)], 1u);
            asm volatile("s_waitcnt vmcnt(0)" ::: "memory");
        } else {
            XB_SPIN(xb_ld(&bar[XB_XGEN(b.x)]) == gen, bar);
            __builtin_amdgcn_fence(__ATOMIC_ACQUIRE, "agent");
            asm volatile("s_waitcnt vmcnt(0)" ::: "memory");
        }
    }
    __syncthreads();
}
#ifndef PROBE_DUP
#define PROBE_DUP -1
#endif
#ifndef PROBE_PMODE
#define PROBE_PMODE 0
#endif

constexpr int T = 16384, D = 4096, AW = 2048, NH = 16, HD = 128, NBLK = 64, BLK = 256, N1 = 18432, GWD = 8192;
constexpr int NWAVES = 8;
constexpr float EPS = 1e-6f;
#ifndef N_LAUNCH
#define N_LAUNCH 1
#endif
constexpr int NPHASE = 9;

constexpr size_t MiB = 1u << 20;
constexpr size_t WS_CTL = 0, CTL_ZERO_BYTES = 1 * MiB;
constexpr int CW_BAR = 4096;
constexpr size_t CB_CNT = 160 * 1024;
constexpr size_t CB_KACC = 256 * 1024;
static_assert((CW_BAR + 9 * 3456) * 4 <= (int)CB_CNT && CB_KACC + 512 * 1024 <= CTL_ZERO_BYTES, "ctl map");
constexpr size_t WS_SS1 = 1 * MiB;
constexpr size_t WS_SS2 = 1108 * MiB;
constexpr size_t WS_COS = 2 * MiB, WS_SIN = 6 * MiB;
constexpr size_t WS_LIST = 10 * MiB;
constexpr size_t WS_ML = 44 * MiB;
constexpr size_t WS_WAP = 52 * MiB, WS_WSP = 68 * MiB, WS_WO = 84 * MiB, WS_W2 = 116 * MiB;
constexpr size_t WS_XB = 132 * MiB, WS_XB8 = 260 * MiB;
#ifndef ZUZV_FP8
#define ZUZV_FP8 1
#endif
constexpr size_t WS_W1Z = 980 * MiB, WS_W18 = 1012 * MiB;
constexpr size_t WS_AO8 = 980 * MiB;
constexpr size_t WS_OP = 132 * MiB;
constexpr size_t WS_Q = 404 * MiB, WS_K = 468 * MiB, WS_V = 532 * MiB, WS_U = 596 * MiB, WS_GV = 660 * MiB;
constexpr size_t WS_G = 724 * MiB;
constexpr size_t WS_AO = 980 * MiB, WS_SO = 1044 * MiB;
constexpr size_t WS_MIX = 132 * MiB, WS_X1B = 260 * MiB;
constexpr size_t WS_TU = 404 * MiB, WS_TV = 468 * MiB;
constexpr size_t WS_S = 724 * MiB;
constexpr size_t WS_XBF = 852 * MiB;
constexpr size_t WS_END = 1112 * MiB;
constexpr size_t LIST_HEAD_STRIDE = 516096;

constexpr int RING_BYTES = 131072;
constexpr int LDS_PRE = RING_BYTES;
constexpr int PEER_WAVE_LDS = 19456;
constexpr int LDS_MISC = 8 * PEER_WAVE_LDS;
constexpr int LDS_BYTES = LDS_MISC + 256;

#define GAS __attribute__((address_space(1)))
typedef unsigned short bf16;
typedef unsigned v4u __attribute__((ext_vector_type(4)));
typedef unsigned v2u __attribute__((ext_vector_type(2)));
typedef float f32x4 __attribute__((ext_vector_type(4)));
typedef float f32x2 __attribute__((ext_vector_type(2)));
typedef float f32x16 __attribute__((ext_vector_type(16)));
typedef short bf16x8 __attribute__((ext_vector_type(8)));
typedef short s16x4 __attribute__((ext_vector_type(4)));
#define LDS_WAIT() asm volatile("s_waitcnt lgkmcnt(0)" ::: "memory")
#define VM_WAIT() asm volatile("s_waitcnt vmcnt(0)" ::: "memory")
#define PIN(v) asm volatile("s_waitcnt vmcnt(0)" : "+v"(v) : : "memory")
typedef __bf16 bf16x2_t __attribute__((ext_vector_type(2)));
__device__ __forceinline__ unsigned cvtpk(float lo, float hi) { const f32x2 v = {lo, hi}; const bf16x2_t r = __builtin_convertvector(v, bf16x2_t); return __builtin_bit_cast(unsigned, r); }
constexpr float S_QKV = 8.0f;
__device__ __forceinline__ bf16x8 pack8(f32x4 a, f32x4 b);
__device__ __forceinline__ bf16x8 fp8x8_to_bf16(v2u w) {
    const f32x2 p0 = __builtin_amdgcn_cvt_pk_f32_fp8((int)w.x, false), p1 = __builtin_amdgcn_cvt_pk_f32_fp8((int)w.x, true), p2 = __builtin_amdgcn_cvt_pk_f32_fp8((int)w.y, false), p3 = __builtin_amdgcn_cvt_pk_f32_fp8((int)w.y, true);
    return pack8((f32x4){p0.x, p0.y, p1.x, p1.y}, (f32x4){p2.x, p2.y, p3.x, p3.y}); }
__device__ __forceinline__ bf16x8 pack8(f32x4 a, f32x4 b) { v4u w; w.x = cvtpk(a[0], a[1]); w.y = cvtpk(a[2], a[3]); w.z = cvtpk(b[0], b[1]); w.w = cvtpk(b[2], b[3]); return __builtin_bit_cast(bf16x8, w); }
__device__ __forceinline__ float clamp448(float x) { return fminf(fmaxf(x, -448.0f), 448.0f); }
__device__ __forceinline__ unsigned pk4_fp8(f32x4 a) { int w = 0; w = __builtin_amdgcn_cvt_pk_fp8_f32(clamp448(a[0]), clamp448(a[1]), w, false); w = __builtin_amdgcn_cvt_pk_fp8_f32(clamp448(a[2]), clamp448(a[3]), w, true); return (unsigned)w; }
#ifndef SGU_FP8
#define SGU_FP8 1
#endif
constexpr float S_SO = 16.0f, S_WSP = 128.0f;
constexpr float S_OP = 32.0f;
constexpr float S_X = 16.0f, S_W1 = 256.0f, S_AO = 64.0f, S_WAP = 128.0f, S_MIX = 16.0f, S_WO = 256.0f;
__device__ __forceinline__ float bflo(unsigned w) { return __uint_as_float(w << 16); }
__device__ __forceinline__ float bfhi(unsigned w) { return __uint_as_float(w & 0xffff0000u); }
__device__ __forceinline__ float wave_sum(float v) {
#pragma unroll
    for (int o = 1; o < 64; o <<= 1) v += __shfl_xor(v, o);
    return v;
}
#define DPP_I(v, ctrl) __builtin_amdgcn_update_dpp(0, (v), (ctrl), 0xF, 0xF, true)
__device__ __forceinline__ int imax(int a, int b) { return a > b ? a : b; }
__device__ __forceinline__ int row16_max_i(int v) { v = imax(v, DPP_I(v, 0xB1)); v = imax(v, DPP_I(v, 0x4E)); v = imax(v, DPP_I(v, 0x141)); v = imax(v, DPP_I(v, 0x140)); return v; }
__device__ __forceinline__ int half32_max_i(int v) { v = row16_max_i(v); const auto r = __builtin_amdgcn_permlane16_swap((unsigned)v, (unsigned)v, false, false); return imax((int)r[0], (int)r[1]); }
__device__ __forceinline__ int wave_max_fast_i(int v) { v = half32_max_i(v); const auto q = __builtin_amdgcn_permlane32_swap((unsigned)v, (unsigned)v, false, false); return imax((int)q[0], (int)q[1]); }
__device__ __forceinline__ float wave_sum_fast(float x) {
    int v = __float_as_int(x);
    x += __int_as_float(DPP_I(v, 0xB1)); v = __float_as_int(x); x += __int_as_float(DPP_I(v, 0x4E)); v = __float_as_int(x);
    x += __int_as_float(DPP_I(v, 0x141)); v = __float_as_int(x); x += __int_as_float(DPP_I(v, 0x140)); v = __float_as_int(x);
    const auto r = __builtin_amdgcn_permlane16_swap((unsigned)v, (unsigned)v, false, false); x = __uint_as_float(r[0]) + __uint_as_float(r[1]); v = __float_as_int(x);
    const auto q = __builtin_amdgcn_permlane32_swap((unsigned)v, (unsigned)v, false, false); return __uint_as_float(q[0]) + __uint_as_float(q[1]);
}
__device__ __forceinline__ int wave_max_i(int v) {
#pragma unroll
    for (int o = 1; o < 64; o <<= 1) { const int t = __shfl_xor(v, o); v = t > v ? t : v; }
    return v;
}
__device__ __forceinline__ unsigned offb(unsigned row, unsigned ch) { return 256u * row + 16u * (ch ^ (((row & 3u) << 2) | ((row >> 2) & 3u))); }
__device__ __forceinline__ bf16x8 tr_read2(unsigned a_lo, unsigned a_hi) {
    s16x4 lo, hi; asm volatile("ds_read_b64_tr_b16 %0, %2\n\tds_read_b64_tr_b16 %1, %3\n\ts_waitcnt lgkmcnt(0)" : "=&v"(lo), "=&v"(hi) : "v"(a_lo), "v"(a_hi) : "memory");
    return (bf16x8){lo[0], lo[1], lo[2], lo[3], hi[0], hi[1], hi[2], hi[3]}; }
__device__ __forceinline__ void tr_read4(unsigned a0, unsigned a1, unsigned a2, unsigned a3, bf16x8& o0, bf16x8& o1) {
    s16x4 r0, r1, r2, r3;
    asm volatile("ds_read_b64_tr_b16 %0, %4\n\tds_read_b64_tr_b16 %1, %5\n\tds_read_b64_tr_b16 %2, %6\n\tds_read_b64_tr_b16 %3, %7\n\ts_waitcnt lgkmcnt(0)"
                 : "=&v"(r0), "=&v"(r1), "=&v"(r2), "=&v"(r3) : "v"(a0), "v"(a1), "v"(a2), "v"(a3) : "memory");
    o0 = (bf16x8){r0[0], r0[1], r0[2], r0[3], r1[0], r1[1], r1[2], r1[3]}; o1 = (bf16x8){r2[0], r2[1], r2[2], r2[3], r3[0], r3[1], r3[2], r3[3]};
}
#define MFMA32(a, b, c) __builtin_amdgcn_mfma_f32_32x32x16_bf16((a), (b), (c), 0, 0, 0)

struct Params {
    const float *x, *norm_mix_g, *w_in, *w_attn_proj, *sgu_norm_g, *sgu_w, *sgu_b, *w_sgu_proj, *w_gate, *b_gate, *w_o, *norm_ffn_g, *peer_wq, *peer_subkeys, *peer_u, *peer_v, *norm_final_g;
    float* out; unsigned char* ws; int ph_lo, ph_hi, li, pad;
};

__device__ __forceinline__ void p0_transpose_item(const float* W, int K, int N, bf16* WT, int row_off, int permqk, const float* gk, LAS float* scr, int item, int lane) {
    const int nblk = N / 32, kb = item / nblk, nb = item % nblk, k0 = 64 * kb, n0 = 32 * nb;
    float wv_[32];
#pragma unroll
    for (int i = 0; i < 32; ++i) wv_[i] = W[(size_t)(k0 + 2 * i + (lane >> 5)) * N + n0 + (lane & 31)];
#pragma unroll
    for (int i = 0; i < 32; ++i) { const int kk = 2 * i + (lane >> 5); const float g = gk ? gk[k0 + kk] : 1.0f; scr[kk * 33 + (lane & 31)] = wv_[i] * g; }
    LDS_WAIT(); asm volatile("" ::: "memory");
    const int c = lane & 7;
    VM_WAIT();
#pragma unroll
    for (int j = 0; j < 4; ++j) { const int n = (lane >> 3) + 8 * j; const LAS float* s = scr + (8 * c) * 33 + n;
        v4u o; o.x = cvtpk(s[0 * 33], s[1 * 33]); o.y = cvtpk(s[2 * 33], s[3 * 33]); o.z = cvtpk(s[4 * 33], s[5 * 33]); o.w = cvtpk(s[6 * 33], s[7 * 33]);
        int nn = n0 + n;
        if (permqk && nn < 4096) { const int d = nn & 127, i = d & 63, hf = d >> 6; nn = (nn & ~127) + 8 * (i >> 2) + 4 * hf + (i & 3); }
        *(v4u*)(WT + (size_t)(row_off + nn) * K + k0 + 8 * c) = o; }
    LDS_WAIT(); asm volatile("" ::: "memory");
}
__device__ __forceinline__ void p0_transpose_item8(const float* W, int K, int N, unsigned char* WT, int row_off, int permqk, const float* gk, float scale, LAS float* scr, int item, int lane) {
    const int nblk = N / 32, kb = item / nblk, nb = item % nblk, k0 = 64 * kb, n0 = 32 * nb;
    float wv_[32];
#pragma unroll
    for (int i = 0; i < 32; ++i) wv_[i] = W[(size_t)(k0 + 2 * i + (lane >> 5)) * N + n0 + (lane & 31)];
#pragma unroll
    for (int i = 0; i < 32; ++i) { const int kk = 2 * i + (lane >> 5); const float g = gk ? gk[k0 + kk] : 1.0f; scr[kk * 33 + (lane & 31)] = wv_[i] * (g * scale); }
    LDS_WAIT(); asm volatile("" ::: "memory");
    const int c = lane & 3;
    VM_WAIT();
#pragma unroll
    for (int j = 0; j < 2; ++j) { const int n = (lane >> 2) + 16 * j; const LAS float* s = scr + (16 * c) * 33 + n;
        v4u o;
        o.x = pk4_fp8((f32x4){s[0 * 33], s[1 * 33], s[2 * 33], s[3 * 33]}); o.y = pk4_fp8((f32x4){s[4 * 33], s[5 * 33], s[6 * 33], s[7 * 33]});
        o.z = pk4_fp8((f32x4){s[8 * 33], s[9 * 33], s[10 * 33], s[11 * 33]}); o.w = pk4_fp8((f32x4){s[12 * 33], s[13 * 33], s[14 * 33], s[15 * 33]});
        int nn = n0 + n;
        if (permqk && nn < 4096) { const int d = nn & 127, i = d & 63, hf = d >> 6; nn = (nn & ~127) + 8 * (i >> 2) + 4 * hf + (i & 3); }
        *(v4u*)(WT + (size_t)(row_off + nn) * K + k0 + 16 * c) = o; }
    LDS_WAIT(); asm volatile("" ::: "memory");
}
__device__ __forceinline__ void p0_prologue(const Params& p, LAS unsigned char* lds, int tid, int lane, int wave) {
    unsigned char* ws = p.ws;
    const int gw = blockIdx.x * NWAVES + wave, NGW = gridDim.x * NWAVES;
    { bf16* XB = (bf16*)(ws + WS_XB); float* ss1 = (float*)(ws + WS_SS1);
      for (int row = gw; row < T; row += NGW) { const f32x4* xr = (const f32x4*)(p.x + (size_t)row * D); float s = 0.f;
          f32x4 xa[8], xb2[8];
#pragma unroll
          for (int j = 0; j < 8; ++j) { xa[j] = xr[128 * j + 2 * lane]; xb2[j] = xr[128 * j + 2 * lane + 1]; }
          VM_WAIT();
#pragma unroll
          for (int j = 0; j < 8; ++j) { PIN(xa[j]); PIN(xb2[j]); }
#pragma unroll
          for (int j = 0; j < 8; ++j) { const f32x4 a = xa[j], b = xb2[j];
              s += (a[0] * a[0] + a[1] * a[1]) + (a[2] * a[2] + a[3] * a[3]) + (b[0] * b[0] + b[1] * b[1]) + (b[2] * b[2] + b[3] * b[3]);
              v4u w; w.x = cvtpk(a[0], a[1]); w.y = cvtpk(a[2], a[3]); w.z = cvtpk(b[0], b[1]); w.w = cvtpk(b[2], b[3]);
              *(v4u*)(ws + WS_XBF + ((size_t)row * D + 512 * j + 8 * lane) * 2) = w;
              v2u w8; w8.x = pk4_fp8(a * S_X); w8.y = pk4_fp8(b * S_X); *(v2u*)(ws + WS_XB8 + (size_t)row * D + 512 * j + 8 * lane) = w8; }
          s = wave_sum(s); if (lane == 0) ss1[row] = s; } }
    { LAS float* scr = (LAS float*)(lds + wave * 16384);
      constexpr int I_IN = (D / 64) * (10240 / 32), I_GT = (D / 64) * (GWD / 32), I_AP = (AW / 64) * (D / 32), I_SP = I_AP, I_WO = (D / 64) * (D / 32);
      constexpr int NIT = I_IN + I_GT + I_AP + I_SP + I_WO;
      for (int it = gw; it < NIT; it += NGW) { int r = it;
          if (r < I_IN) { const int nb = r % (10240 / 32);
#if ZUZV_FP8
              (void)nb; p0_transpose_item8(p.w_in, D, 10240, ws + WS_W18, 0, 1, p.norm_mix_g, S_W1, scr, r, lane);
#else
              if (nb * 32 < 6144) p0_transpose_item8(p.w_in, D, 10240, ws + WS_W18, 0, 1, p.norm_mix_g, S_W1, scr, r, lane);
              else p0_transpose_item(p.w_in, D, 10240, (bf16*)(ws + WS_W1Z), -6144, 0, p.norm_mix_g, scr, r, lane);
#endif
              continue; } r -= I_IN;
          if (r < I_GT) { p0_transpose_item8(p.w_gate, D, GWD, ws + WS_W18, ZUZV_FP8 ? 10240 : 6144, 0, p.norm_mix_g, S_W1, scr, r, lane); continue; } r -= I_GT;
          if (r < I_AP) { p0_transpose_item8(p.w_attn_proj, AW, D, ws + WS_WAP, 0, 0, nullptr, S_WAP, scr, r, lane); continue; } r -= I_AP;
          if (r < I_SP) { if (SGU_FP8) p0_transpose_item8(p.w_sgu_proj, AW, D, ws + WS_WSP, 0, 0, nullptr, S_WSP, scr, r, lane); else p0_transpose_item(p.w_sgu_proj, AW, D, (bf16*)(ws + WS_WSP), 0, 0, nullptr, scr, r, lane); continue; } r -= I_SP;
          p0_transpose_item8(p.w_o, D, D, ws + WS_WO, 0, 0, nullptr, S_WO, scr, r, lane); } }
    { bf16* W2 = (bf16*)(ws + WS_W2);
      for (int it = gw; it < 16 * 128; it += NGW) { const int g16 = it >> 7, k0 = (it & 127) * 32, hh = lane >> 5, c = lane & 31;
          const float* wp = p.peer_wq + (size_t)(k0 + c) * 2048 + g16 * 128 + 8 * hh; bf16x8 Bf[8];
#pragma unroll
          for (int s = 0; s < 8; ++s) Bf[s] = pack8(*(const f32x4*)(wp + 16 * s), *(const f32x4*)(wp + 16 * s + 4));
          float gf = p.norm_ffn_g[k0 + c]; PIN(gf);
          for (int nt = 0; nt < 4; ++nt) { f32x16 acc = {};
              const float* sp = p.peer_subkeys + ((size_t)g16 * 128 + nt * 32 + c) * 128 + 8 * hh;
#pragma unroll
              for (int s = 0; s < 8; ++s) { f32x4 a0 = *(const f32x4*)(sp + 16 * s), a1 = *(const f32x4*)(sp + 16 * s + 4); PIN(a0); PIN(a1); acc = MFMA32(pack8(a0, a1), Bf[s], acc); }
              VM_WAIT();
#pragma unroll
              for (int r = 0; r < 16; ++r) { const int n = nt * 32 + (r & 3) + 8 * (r >> 2) + 4 * hh;
                  W2[(size_t)(g16 * 128 + n) * D + k0 + c] = (bf16)(cvtpk(acc[r] * gf, 0.f) & 0xffffu); } } } }
    { float* cosT = (float*)(ws + WS_COS); float* sinT = (float*)(ws + WS_SIN);
      for (int i = blockIdx.x * 512 + tid; i < T * 64; i += gridDim.x * 512) { const int t = i >> 6, f = i & 63;
          const float inv = exp2f(-(float)f * 0.20762050593046014f);
          const float ang = (float)t * inv;
          double rev = (double)ang * 0.15915494309189535; rev -= __builtin_rint(rev);
          const float fr = (float)rev;
          cosT[i] = __builtin_amdgcn_cosf(fr); sinT[i] = __builtin_amdgcn_sinf(fr); } }
}

__device__ __forceinline__ bool better(float a, int ja, float b, int jb) { return a > b || (a == b && ja < jb); }
__device__ __forceinline__ void top3_insert(float v, int j, float& v0, int& j0, float& v1, int& j1, float& v2, int& j2) {
    const bool b0 = better(v, j, v0, j0), b1 = better(v, j, v1, j1), b2 = better(v, j, v2, j2);
    v2 = b1 ? v1 : (b2 ? v : v2); j2 = b1 ? j1 : (b2 ? j : j2);
    v1 = b0 ? v0 : (b1 ? v : v1); j1 = b0 ? j0 : (b1 ? j : j1);
    v0 = b0 ? v : v0; j0 = b0 ? j : j0;
}
__device__ __forceinline__ size_t list_off(int h, int j) { return (size_t)h * LIST_HEAD_STRIDE + (size_t)256 * (63 * j - (j * (j - 1)) / 2); }
template <int NU>
__device__ __forceinline__ void moba_select_multi(const Params& p, int u0, int ustep, int lane, int wave) {
    unsigned char* ws = p.ws;
    const bf16* Q = (const bf16*)(ws + WS_Q); const float* kacc = (const float*)(ws + CB_KACC);
    unsigned* cnt = (unsigned*)(ws + CB_CNT); unsigned* list = (unsigned*)(ws + WS_LIST); f32x2* ML = (f32x2*)(ws + WS_ML);
    const int hh = lane >> 5, c = lane & 31;
    const float NINF = -__builtin_inff();
    float v0[NU], v1[NU], v2[NU]; int j0[NU], j1[NU], j2[NU]; bf16x8 qf[NU][8]; unsigned pos[NU][3];
#pragma unroll
    for (int i = 0; i < NU; ++i) { const int u = u0 + i * ustep; const int b = u & 63, h = u >> 6, t = b * BLK + wave * 32 + c;
        v0[i] = NINF; v1[i] = NINF; v2[i] = NINF; j0[i] = 1000; j1[i] = 1001; j2[i] = 1002;
        if (u < 1024 && b > 0) { const unsigned char* qp = (const unsigned char*)Q + (size_t)t * AW + h * HD + 8 * hh; v2u qraw[8];
#pragma unroll
            for (int s = 0; s < 8; ++s) qraw[s] = *(const v2u*)(qp + 16 * s);
#pragma unroll
            for (int s = 0; s < 8; ++s) qf[i][s] = fp8x8_to_bf16(qraw[s]); } }
#pragma unroll
    for (int i = 0; i < NU; ++i) { const int u = u0 + i * ustep; const int b = u & 63, h = u >> 6;
        if (u < 1024 && b > 0) {
#pragma unroll
            for (int jt = 0; jt < 2; ++jt) if (32 * jt < b) { f32x16 g = {};
                const float* kp = kacc + ((size_t)h * 64 + 32 * jt + c) * 128 + 8 * hh;
#pragma unroll
                for (int s = 0; s < 8; ++s) g = MFMA32(pack8(*(const f32x4*)(kp + 16 * s), *(const f32x4*)(kp + 16 * s + 4)), qf[i][s], g);
#pragma unroll
                for (int r = 0; r < 16; ++r) { const int j = 32 * jt + (r & 3) + 8 * (r >> 2) + 4 * hh; top3_insert(j < b ? g[r] : NINF, j, v0[i], j0[i], v1[i], j1[i], v2[i], j2[i]); } }
            const float pv0 = __shfl_xor(v0[i], 32), pv1 = __shfl_xor(v1[i], 32), pv2 = __shfl_xor(v2[i], 32);
            const int pj0 = __shfl_xor(j0[i], 32), pj1 = __shfl_xor(j1[i], 32), pj2 = __shfl_xor(j2[i], 32);
            top3_insert(pv0, pj0, v0[i], j0[i], v1[i], j1[i], v2[i], j2[i]); top3_insert(pv1, pj1, v0[i], j0[i], v1[i], j1[i], v2[i], j2[i]); top3_insert(pv2, pj2, v0[i], j0[i], v1[i], j1[i], v2[i], j2[i]);
        } }
    VM_WAIT();
#pragma unroll
    for (int i = 0; i < NU; ++i) { const int u = u0 + i * ustep; const int b = u & 63, h = u >> 6; const int nsel = b < 3 ? b : 3;
#pragma unroll
        for (int r = 0; r < 3; ++r) { const int j = r == 0 ? j0[i] : (r == 1 ? j1[i] : j2[i]); pos[i][r] = 0u; if (u < 1024 && hh == 0 && r < nsel) pos[i][r] = atomicAdd(cnt + h * 64 + j, 1u); } }
    VM_WAIT();
#pragma unroll
    for (int i = 0; i < NU; ++i)
#pragma unroll
        for (int r = 0; r < 3; ++r) PIN(pos[i][r]);
#pragma unroll
    for (int i = 0; i < NU; ++i) { const int u = u0 + i * ustep; const int b = u & 63, h = u >> 6, t = b * BLK + wave * 32 + c; const int nsel = b < 3 ? b : 3;
        if (u < 1024 && hh == 0) {
#pragma unroll
            for (int r = 0; r < 3; ++r) { const int j = r == 0 ? j0[i] : (r == 1 ? j1[i] : j2[i]);
                if (r < nsel) list[list_off(h, j) + pos[i][r]] = (unsigned)t | ((unsigned)r << 14);
                else ML[((size_t)r * T + t) * 16 + h] = (f32x2){NINF, 0.f}; } } }
}
__device__ __forceinline__ void sgu_unit(const Params& p, LAS unsigned char* lds, int cch, int g, int tid, int lane, int wave) {
    unsigned char* ws = p.ws;
    const bf16* GV = (const bf16*)(ws + WS_GV); const bf16* U = (const bf16*)(ws + WS_U); bf16* SO = (bf16*)(ws + WS_SO);
    LAS float* rsq = (LAS float*)(lds + 32768);
    f32x4 wpa[8], wpb[8];
    { const int tt0 = wave >> 1, hh0 = lane >> 5, c0 = lane & 31; const float* wrow0 = p.sgu_w + ((size_t)g * 128 + 32 * tt0 + c0) * 128 + 8 * hh0;
#pragma unroll
      for (int ks = 0; ks < 8; ++ks) if (ks < 2 * tt0 + 2) { wpa[ks] = *(const f32x4*)(wrow0 + 16 * ks); wpb[ks] = *(const f32x4*)(wrow0 + 16 * ks + 4); } }
    v4u gvw[4]; unsigned short uraw[2][16]; float bb[16], ngv[2];
#pragma unroll
    for (int i = 0; i < 4; ++i) { const int id = tid + 512 * i, row = id >> 4, ch = id & 15; gvw[i] = *(const v4u*)(GV + (size_t)(cch * 128 + row) * AW + g * 128 + ch * 8); }
    { const int tt0 = wave >> 1, dt00 = (wave & 1) * 2, hh0 = lane >> 5, c0 = lane & 31;
#pragma unroll
      for (int r = 0; r < 16; ++r) { const int tl = 32 * tt0 + (r & 3) + 8 * (r >> 2) + 4 * hh0; bb[r] = p.sgu_b[g * 128 + tl];
#pragma unroll
          for (int d2 = 0; d2 < 2; ++d2) uraw[d2][r] = *(const unsigned short*)(U + (size_t)(cch * 128 + tl) * AW + g * 128 + 32 * (dt00 + d2) + c0); }
#pragma unroll
      for (int d2 = 0; d2 < 2; ++d2) ngv[d2] = p.sgu_norm_g[g * 128 + 32 * (dt00 + d2) + c0]; }
    __syncthreads();
    VM_WAIT();
#pragma unroll
    for (int i = 0; i < 4; ++i) { const int id = tid + 512 * i, row = id >> 4, ch = id & 15;
        v4u w = gvw[i]; PIN(w);
        *(LAS v4u*)(lds + offb(row, ch)) = w;
        float s = bflo(w.x) * bflo(w.x) + bfhi(w.x) * bfhi(w.x) + bflo(w.y) * bflo(w.y) + bfhi(w.y) * bfhi(w.y)
                + bflo(w.z) * bflo(w.z) + bfhi(w.z) * bfhi(w.z) + bflo(w.w) * bflo(w.w) + bfhi(w.w) * bfhi(w.w);
        s += __shfl_xor(s, 1); s += __shfl_xor(s, 2); s += __shfl_xor(s, 4); s += __shfl_xor(s, 8);
        if (ch == 0) rsq[row] = rsqrtf(s * (1.0f / 128.0f) + EPS); }
    __syncthreads();
    const int tt = wave >> 1, dt0 = (wave & 1) * 2, hh = lane >> 5, c = lane & 31;
    const int blk = (lane >> 4) & 1, q4 = (lane & 15) >> 2, pp = lane & 3;
    f32x16 acc[2] = {};
    const float* wrow = p.sgu_w + ((size_t)g * 128 + 32 * tt + c) * 128 + 8 * hh;
    const unsigned lbase = (unsigned)(uintptr_t)lds;
    VM_WAIT();
#pragma unroll
    for (int ks = 0; ks < 8; ++ks) if (ks < 2 * tt + 2) {
        const int s0 = 16 * ks + 8 * hh, trow = 32 * tt + c;
        f32x4 wa = wpa[ks], wb = wpb[ks]; PIN(wa); PIN(wb);
        const f32x4 ra = *(const LAS f32x4*)(rsq + s0), rb = *(const LAS f32x4*)(rsq + s0 + 4);
#pragma unroll
        for (int e = 0; e < 4; ++e) { wa[e] = (s0 + e <= trow) ? wa[e] * ra[e] : 0.f; wb[e] = (s0 + 4 + e <= trow) ? wb[e] * rb[e] : 0.f; }
        const bf16x8 A = pack8(wa, wb);
#pragma unroll
        for (int d2 = 0; d2 < 2; ++d2) { const int dt = dt0 + d2;
            const bf16x8 B = tr_read2(lbase + offb(16 * ks + 8 * hh + q4, 4 * dt + 2 * blk + (pp >> 1)) + 8 * (pp & 1),
                                      lbase + offb(16 * ks + 8 * hh + 4 + q4, 4 * dt + 2 * blk + (pp >> 1)) + 8 * (pp & 1));
            acc[d2] = MFMA32(A, B, acc[d2]); }
    }
#pragma unroll
    for (int d2 = 0; d2 < 2; ++d2) { const int d = 32 * (dt0 + d2) + c; float ng = ngv[d2]; PIN(ng);
        float uu[16];
#pragma unroll
        for (int r = 0; r < 16; ++r) { unsigned ur = uraw[d2][r]; PIN(ur); PIN(bb[r]); uu[r] = __uint_as_float(ur << 16); }
#pragma unroll
        for (int r = 0; r < 16; ++r) { const int tl = 32 * tt + (r & 3) + 8 * (r >> 2) + 4 * hh;
            const size_t o = (size_t)(cch * 128 + tl) * AW + g * 128 + d;
#ifndef PROBE_WV
#define PROBE_WV 1.0f
#endif
#if SGU_FP8
            ((unsigned char*)SO)[o] = (unsigned char)(__builtin_amdgcn_cvt_pk_fp8_f32(clamp448(uu[r] * (PROBE_WV * acc[d2][r] * ng + bb[r]) * S_SO), 0.f, 0, false) & 0xff); } }
#else
            SO[o] = (bf16)(cvtpk(uu[r] * (PROBE_WV * acc[d2][r] * ng + bb[r]), 0.f) & 0xffffu); } }
#endif
}

__device__ __forceinline__ pg8::i32x8 cat8(v4u a, v4u b) { return (pg8::i32x8){(int)a.x, (int)a.y, (int)a.z, (int)a.w, (int)b.x, (int)b.y, (int)b.z, (int)b.w}; }
#define MFMA64(A, B, C) __builtin_amdgcn_mfma_scale_f32_32x32x64_f8f6f4((A), (B), (C), 0, 0, 0, 0x7f7f7f7f, 0, 0x7f7f7f7f)
__device__ __forceinline__ void attn_item(const Params& p, LAS unsigned char* lds, int h, int jblk, bool own, const unsigned* lst, int cnt, int ti, bool newkv, int tid, int lane, int wave) {
    unsigned char* ws = p.ws;
    const unsigned char* Q = ws + WS_Q; const unsigned char* Kg = ws + WS_K + (size_t)(jblk * BLK) * AW + h * HD; const unsigned char* Vg = ws + WS_V + (size_t)(jblk * BLK) * AW + h * HD;
    f32x2* ML = (f32x2*)(ws + WS_ML);
    asm volatile("" : "+v"(lane));
    const int hh = lane >> 5, c = lane & 31;
    constexpr unsigned VT0 = 32768u;
    if (newkv) {
        __syncthreads();
        v4u kr[4], vr[4];
        const int vg4 = 4 * (tid & 63), vch = tid >> 6;
#pragma unroll
        for (int i = 0; i < 4; ++i) { const int id = tid + 512 * i, row = id >> 3, ch = id & 7; kr[i] = *(const v4u*)(Kg + (size_t)row * AW + ch * 16); vr[i] = *(const v4u*)(Vg + (size_t)(vg4 + i) * AW + vch * 16); }
#pragma unroll
        for (int i = 0; i < 4; ++i) { const int id = tid + 512 * i, row = id >> 3, ch = id & 7; *(LAS v4u*)(lds + row * 128 + 16 * (ch ^ ((row >> 1) & 7))) = kr[i]; }
        { const int kk = vg4 & 31, pos = 64 * (vg4 >> 6) + 32 * ((kk >> 2) & 1) + 16 * ((vg4 >> 5) & 1) + 4 * (kk >> 3);
          LAS unsigned char* vt = lds + VT0 + (16 * vch) * 256 + (pos & 15);
#pragma unroll
          for (int q4 = 0; q4 < 4; ++q4) {
              const unsigned k0 = q4 == 0 ? vr[0].x : (q4 == 1 ? vr[0].y : (q4 == 2 ? vr[0].z : vr[0].w)), k1 = q4 == 0 ? vr[1].x : (q4 == 1 ? vr[1].y : (q4 == 2 ? vr[1].z : vr[1].w));
              const unsigned k2 = q4 == 0 ? vr[2].x : (q4 == 1 ? vr[2].y : (q4 == 2 ? vr[2].z : vr[2].w)), k3 = q4 == 0 ? vr[3].x : (q4 == 1 ? vr[3].y : (q4 == 2 ? vr[3].z : vr[3].w));
              const unsigned t0 = __builtin_amdgcn_perm(k1, k0, 0x05010400u), t1 = __builtin_amdgcn_perm(k1, k0, 0x07030602u), t2 = __builtin_amdgcn_perm(k3, k2, 0x05010400u), t3 = __builtin_amdgcn_perm(k3, k2, 0x07030602u);
              const unsigned d0 = __builtin_amdgcn_perm(t2, t0, 0x05040100u), d1 = __builtin_amdgcn_perm(t2, t0, 0x07060302u), d2 = __builtin_amdgcn_perm(t3, t1, 0x05040100u), d3 = __builtin_amdgcn_perm(t3, t1, 0x07060302u);
              const int b0 = 4 * q4;
              *(LAS unsigned*)(vt + (b0 + 0) * 256 + 16 * ((pos >> 4) ^ (b0 + 0))) = d0; *(LAS unsigned*)(vt + (b0 + 1) * 256 + 16 * ((pos >> 4) ^ (b0 + 1))) = d1;
              *(LAS unsigned*)(vt + (b0 + 2) * 256 + 16 * ((pos >> 4) ^ (b0 + 2))) = d2; *(LAS unsigned*)(vt + (b0 + 3) * 256 + 16 * ((pos >> 4) ^ (b0 + 3))) = d3; } } }
    int t, slot; bool valid;
    if (own) { t = jblk * BLK + wave * 32 + c; slot = 3; valid = true; }
    else { const int qi = ti * 256 + wave * 32 + c; valid = qi < cnt; const unsigned e = lst[valid ? qi : 0]; t = (int)(e & 16383u); slot = (int)(e >> 14); }
    const bool wactive = own || (ti * 256 + wave * 32 < cnt);
    pg8::i32x8 qf8[2];
    { const unsigned char* qp = Q + (size_t)t * AW + h * HD + 32 * hh;
#pragma unroll
      for (int cq = 0; cq < 2; ++cq) qf8[cq] = cat8(*(const v4u*)(qp + 64 * cq), *(const v4u*)(qp + 64 * cq + 16)); }
    if (newkv) __syncthreads();
    if (!wactive) return;
    const float NINF = -__builtin_inff();
    f32x16 sc[8];
#pragma unroll
    for (int kt = 0; kt < 8; ++kt) {
        sc[kt] = (f32x16){};
        if (!own || kt <= wave) { const int key = 32 * kt + c, sw = (key >> 1) & 7;
#pragma unroll
            for (int cq = 0; cq < 2; ++cq) { const int c0 = 4 * cq + 2 * hh;
                const pg8::i32x8 kf = cat8(*(const LAS v4u*)(lds + key * 128 + 16 * (c0 ^ sw)), *(const LAS v4u*)(lds + key * 128 + 16 * ((c0 + 1) ^ sw)));
                sc[kt] = MFMA64(kf, qf8[cq], sc[kt]); }
        }
    }
    if (own) {
#pragma unroll
        for (int kt = 0; kt < 8; ++kt) {
            if (kt == wave) {
#pragma unroll
                for (int r = 0; r < 16; ++r) { const int kl = (r & 3) + 8 * (r >> 2) + 4 * hh; if (kl > c) sc[kt][r] = NINF; }
            } else if (kt > wave) {
#pragma unroll
                for (int r = 0; r < 16; ++r) sc[kt][r] = NINF;
            }
        }
    }
    float mx = NINF;
#pragma unroll
    for (int kt = 0; kt < 8; ++kt)
#pragma unroll
        for (int r = 0; r < 16; ++r) mx = fmaxf(mx, sc[kt][r]);
    mx = fmaxf(mx, __shfl_xor(mx, 32));
    constexpr float C = 0.08838834764831845f * 1.4426950408889634f / (S_QKV * S_QKV);
    constexpr float S_P = 128.0f;
    const float mC = mx * C, mCs = mC - 7.0f; float ls = 0.f;
    pg8::i32x8 pf8[4];
#pragma unroll
    for (int kt = 0; kt < 8; ++kt) {
#pragma unroll
        for (int r = 0; r < 16; ++r) { const float e = __builtin_amdgcn_exp2f(sc[kt][r] * C - mCs); sc[kt][r] = e; ls += e; }
#pragma unroll
        for (int j = 0; j < 4; ++j) { int w = 0; w = __builtin_amdgcn_cvt_pk_fp8_f32(sc[kt][4 * j], sc[kt][4 * j + 1], w, false); w = __builtin_amdgcn_cvt_pk_fp8_f32(sc[kt][4 * j + 2], sc[kt][4 * j + 3], w, true); pf8[kt >> 1][4 * (kt & 1) + j] = w; }
    }
    ls += __shfl_xor(ls, 32);
    int l3 = lane; asm volatile("" : "+v"(l3), "+v"(ls));
    const int c3 = l3 & 31, hh3 = l3 >> 5;
    f32x16 o[4] = {};
#pragma unroll
    for (int pq = 0; pq < 4; ++pq) {
        if (!own || 2 * pq <= wave) {
#pragma unroll
            for (int dt = 0; dt < 4; ++dt) { const int d = 32 * dt + c3, c0 = 4 * pq + 2 * hh3, sw = c3 & 15;
                const pg8::i32x8 vf = cat8(*(const LAS v4u*)(lds + VT0 + d * 256 + 16 * (c0 ^ sw)), *(const LAS v4u*)(lds + VT0 + d * 256 + 16 * ((c0 + 1) ^ sw)));
                o[dt] = MFMA64(vf, pf8[pq], o[dt]); }
        }
    }
    VM_WAIT();
    { const float inv = S_OP / (ls * S_QKV); unsigned char* rowp = (unsigned char*)(ws + WS_OP) + ((((size_t)slot * T + t) * 16 + h) * 128) + (hh ? 16 : 0);
#pragma unroll
      for (int dt = 0; dt < 4; ++dt) { unsigned g0, g1, g2, g3;
          g0 = pk4_fp8((f32x4){o[dt][0], o[dt][1], o[dt][2], o[dt][3]} * inv); g1 = pk4_fp8((f32x4){o[dt][4], o[dt][5], o[dt][6], o[dt][7]} * inv);
          g2 = pk4_fp8((f32x4){o[dt][8], o[dt][9], o[dt][10], o[dt][11]} * inv); g3 = pk4_fp8((f32x4){o[dt][12], o[dt][13], o[dt][14], o[dt][15]} * inv);
          { const auto r = __builtin_amdgcn_permlane32_swap(g0, g1, false, false); g0 = r[0]; g1 = r[1]; }
          { const auto r = __builtin_amdgcn_permlane32_swap(g2, g3, false, false); g2 = r[0]; g3 = r[1]; }
          { const auto r = __builtin_amdgcn_permlane32_swap(g0, g2, false, false); g0 = r[0]; g2 = r[1]; }
          { const auto r = __builtin_amdgcn_permlane32_swap(g1, g3, false, false); g1 = r[0]; g3 = r[1]; }
          if (valid) *(v4u*)(rowp + 32 * dt) = (v4u){g0, g1, g2, g3}; }
      if (valid && hh == 0) ML[((size_t)slot * T + t) * 16 + h] = (f32x2){mC, ls * (1.0f / S_P)}; }
}
__device__ __forceinline__ void attn_phase(const Params& p, LAS unsigned char* lds, int tid, int lane, int wave) {
    unsigned char* ws = p.ws;
    const unsigned* cntg = (const unsigned*)(ws + CB_CNT); const unsigned* list = (const unsigned*)(ws + WS_LIST);
    LAS int* pre = (LAS int*)(lds + LDS_PRE); LAS int* wsum = (LAS int*)(lds + LDS_MISC) + 16;
    { const int a = (int)((cntg[2 * tid] + 255u) >> 8) + 1, b2 = (int)((cntg[2 * tid + 1] + 255u) >> 8) + 1, s = a + b2; int x = s;
#pragma unroll
      for (int o = 1; o < 64; o <<= 1) { const int y = __shfl_up(x, o); if (lane >= o) x += y; }
      if (lane == 63) wsum[wave] = x;
      __syncthreads();
      int woff = 0;
      for (int w = 0; w < wave; ++w) woff += wsum[w];
      const int ex = woff + x - s; pre[2 * tid] = ex; pre[2 * tid + 1] = ex + a;
      __syncthreads(); }
    int nitems = 0;
    for (int w = 0; w < NWAVES; ++w) nitems += wsum[w];
    const int i0 = (int)(((long long)nitems * (int)blockIdx.x) / (int)gridDim.x), i1 = (int)(((long long)nitems * ((int)blockIdx.x + 1)) / (int)gridDim.x);
    int cur = -1;
    for (int it = i0; it < i1; ++it) {
        int lo = 0, hi = 1023;
        while (lo < hi) { const int mid = (lo + hi + 1) >> 1; if (pre[mid] <= it) lo = mid; else hi = mid - 1; }
        const int h = lo >> 6, j = lo & 63, ti = it - pre[lo], cnt = (int)cntg[lo]; const bool newkv = lo != cur; cur = lo;
        if (ti == ((cnt + 255) >> 8)) attn_item(p, lds, h, j, true, nullptr, 0, 0, newkv, tid, lane, wave);
        else attn_item(p, lds, h, j, false, list + list_off(h, j), cnt, ti, newkv, tid, lane, wave);
    }
}
__device__ __forceinline__ void attn_combine(const Params& p, int lane, int wave) {
    unsigned char* ws = p.ws;
    const unsigned char* OP = ws + WS_OP; const f32x2* ML = (const f32x2*)(ws + WS_ML); unsigned char* AO8 = ws + WS_AO8;
    const int gw = blockIdx.x * NWAVES + wave, NGW = gridDim.x * NWAVES;
    for (int i0 = gw; i0 < T * 4; i0 += 4 * NGW) {
        f32x2 ml[4][4]; v2u ov4[4][4];
#pragma unroll
        for (int q = 0; q < 4; ++q) { const int i = i0 + q * NGW; if (i < T * 4) { const int t = i >> 2, h = (i & 3) * 4 + (lane >> 4), d0 = (lane & 15) * 8;
#pragma unroll
            for (int s = 0; s < 4; ++s) { ml[q][s] = ML[((size_t)s * T + t) * 16 + h]; ov4[q][s] = *(const v2u*)(OP + (((size_t)s * T + t) * 16 + h) * 128 + d0); } } }
        VM_WAIT();
#pragma unroll
        for (int q = 0; q < 4; ++q)
#pragma unroll
            for (int s = 0; s < 4; ++s) { PIN(ml[q][s]); PIN(ov4[q][s]); }
#pragma unroll
        for (int q = 0; q < 4; ++q) { const int i = i0 + q * NGW; if (i < T * 4) { const int t = i >> 2, h = (i & 3) * 4 + (lane >> 4), d0 = (lane & 15) * 8;
            float M = -__builtin_inff();
#pragma unroll
            for (int s = 0; s < 4; ++s) { if (ml[q][s].y > 0.f) M = fmaxf(M, ml[q][s].x); }
            float w[4], W = 0.f;
#pragma unroll
            for (int s = 0; s < 4; ++s) { w[s] = ml[q][s].y > 0.f ? ml[q][s].y * __builtin_amdgcn_exp2f(ml[q][s].x - M) : 0.f; W += w[s]; }
            const float iW = 1.0f / W; float acc[8] = {0.f, 0.f, 0.f, 0.f, 0.f, 0.f, 0.f, 0.f};
#pragma unroll
            for (int s = 0; s < 4; ++s) { const v2u v = ov4[q][s]; const float ww = w[s] * iW * (1.0f / S_OP);
                if (ww > 0.f) { const f32x2 p0 = __builtin_amdgcn_cvt_pk_f32_fp8((int)v.x, false), p1 = __builtin_amdgcn_cvt_pk_f32_fp8((int)v.x, true), p2 = __builtin_amdgcn_cvt_pk_f32_fp8((int)v.y, false), p3 = __builtin_amdgcn_cvt_pk_f32_fp8((int)v.y, true);
                                acc[0] += ww * p0.x; acc[1] += ww * p0.y; acc[2] += ww * p1.x; acc[3] += ww * p1.y; acc[4] += ww * p2.x; acc[5] += ww * p2.y; acc[6] += ww * p3.x; acc[7] += ww * p3.y; } }
            v2u o; o.x = pk4_fp8((f32x4){acc[0], acc[1], acc[2], acc[3]} * S_AO); o.y = pk4_fp8((f32x4){acc[4], acc[5], acc[6], acc[7]} * S_AO);
            *(v2u*)(AO8 + (size_t)t * AW + h * HD + d0) = o; } }
    }
}
constexpr float PEER_SU = 128.0f, PEER_SV = 4.0f;
constexpr int PEER_ROWB = 2048;
__device__ __forceinline__ float clamp6(float x) { return fminf(fmaxf(x, -6.0f), 6.0f); }
__device__ __forceinline__ void peer_pack_row_piece4(const float* src, const f32x4 (&g)[4][4], float scale, unsigned char* dst, int L) {
    unsigned w[8]; f32x4 v[4][4];
#pragma unroll
    for (int c = 0; c < 4; ++c)
#pragma unroll
        for (int j = 0; j < 4; ++j) v[c][j] = *(const f32x4*)(src + 1024 * c + 16 * L + 4 * j);
    VM_WAIT();
#pragma unroll
    for (int c = 0; c < 4; ++c) {
#pragma unroll
        for (int j = 0; j < 4; ++j) PIN(v[c][j]);
#pragma unroll
        for (int j = 0; j < 4; ++j)
#pragma unroll
            for (int e = 0; e < 4; ++e) v[c][j][e] = clamp6(v[c][j][e] * g[c][j][e] * scale);
#pragma unroll
        for (int d = 0; d < 2; ++d) { unsigned x = 0;
            x = __builtin_amdgcn_cvt_scalef32_pk_fp4_f32(x, v[c][2 * d][0], v[c][2 * d][1], 1.0f, 0); x = __builtin_amdgcn_cvt_scalef32_pk_fp4_f32(x, v[c][2 * d][2], v[c][2 * d][3], 1.0f, 1);
            x = __builtin_amdgcn_cvt_scalef32_pk_fp4_f32(x, v[c][2 * d + 1][0], v[c][2 * d + 1][1], 1.0f, 2); x = __builtin_amdgcn_cvt_scalef32_pk_fp4_f32(x, v[c][2 * d + 1][2], v[c][2 * d + 1][3], 1.0f, 3);
            w[2 * c + d] = x; }
    }
    *(v4u*)(dst + 16 * L) = (v4u){w[0], w[1], w[2], w[3]}; *(v4u*)(dst + 1024 + 16 * L) = (v4u){w[4], w[5], w[6], w[7]};
}
__device__ __forceinline__ void peer_tables(const Params& p, int tid) {
    unsigned char* ws = p.ws; unsigned char* TU = ws + WS_TU; unsigned char* TV = ws + WS_TV;
    const int L = tid & 63;
    f32x4 gu[4][4], g1[4][4];
#pragma unroll
    for (int c = 0; c < 4; ++c)
#pragma unroll
        for (int j = 0; j < 4; ++j) { gu[c][j] = *(const f32x4*)(p.norm_ffn_g + 1024 * c + 16 * L + 4 * j); g1[c][j] = (f32x4){1.f, 1.f, 1.f, 1.f}; }
    VM_WAIT();
#pragma unroll
    for (int c = 0; c < 4; ++c)
#pragma unroll
        for (int j = 0; j < 4; ++j) PIN(gu[c][j]);
    for (size_t i = (size_t)blockIdx.x * 512 + tid; i < (size_t)16384 * 64; i += (size_t)gridDim.x * 512) { const size_t e = i >> 6;
        peer_pack_row_piece4(p.peer_u + e * D, gu, PEER_SU, TU + e * PEER_ROWB, L);
        peer_pack_row_piece4(p.peer_v + e * D, g1, PEER_SV, TV + e * PEER_ROWB, L); }
}
#ifndef PROBE_SKIP_PEER
#define PROBE_SKIP_PEER 0
#endif
#ifndef PROBE_SP
#define PROBE_SP 1.0f
#endif
__device__ __forceinline__ int f2ord(float f) { const int b = __float_as_int(f); return b ^ ((b >> 31) & 0x7fffffff); }
__device__ __forceinline__ void peer_phase(const Params& p, LAS unsigned char* lds, int lane, int wave, bool dry = false, int pmode = 0) {
    unsigned char* ws = p.ws;
    const float* S = (const float*)(ws + WS_S); const float* ss2 = (const float*)(ws + WS_SS2);
    const bf16* X1B = (const bf16*)(ws + WS_X1B); const unsigned char* TU = ws + WS_TU; const unsigned char* TV = ws + WS_TV;
    LAS unsigned char* wl = lds + wave * PEER_WAVE_LDS;
    LAS float* sl = (LAS float*)wl;
    LAS int* kl = (LAS int*)(wl + 8192);
    LAS int* exl = (LAS int*)(wl + 18432);
    LAS float* gtl = (LAS float*)(wl + 18432 + 512);
    const int gw = blockIdx.x * NWAVES + wave, NGW = gridDim.x * NWAVES;
    const int IMIN = (int)0x80000000;
    int ci = 0, cb = 0;
    { const int th[15] = {16, 24, 29, 33, 36, 38, 40, 42, 43, 44, 45, 46, 47, 48, 49};
#pragma unroll
      for (int k = 0; k < 15; ++k) if (lane >= th[k]) { ci = k + 1; cb = th[k]; } }
    const int cj = (lane - cb) & 15; const bool cvalid = lane < 50;
    const __amdgpu_buffer_rsrc_t rsU = __builtin_amdgcn_make_buffer_rsrc((void*)TU, 0, -1, 0x00020000), rsV = __builtin_amdgcn_make_buffer_rsrc((void*)TV, 0, -1, 0x00020000);
    for (int t = gw; t < T; t += NGW) {
        const float rstd2 = rsqrtf(wave_sum(ss2[(size_t)t * 64 + lane]) * (1.0f / 4096.0f) + EPS);
#pragma unroll
        for (int c = 0; c < 8; ++c) { typedef _Float16 h4_t __attribute__((ext_vector_type(4)));
            const h4_t hv = *(const h4_t*)((const _Float16*)S + (size_t)t * 2048 + 256 * c + 4 * lane);
            const f32x4 svc = {(float)hv.x, (float)hv.y, (float)hv.z, (float)hv.w}; *(LAS f32x4*)(sl + 256 * c + 4 * lane) = svc; }
        LDS_WAIT();
#define PEER_CE(a, b) { const int hi_ = a > b ? a : b, lo_ = a > b ? b : a; a = hi_; b = lo_; }
#define PEER_POP(k, m) { const bool p_ = k[0] == m; k[0] = p_ ? k[1] : k[0]; k[1] = p_ ? k[2] : k[1]; k[2] = p_ ? k[3] : k[2]; k[3] = p_ ? IMIN : k[3]; }
#pragma unroll 1
        for (int c2 = 0; c2 < 4; ++c2) {
            int ka[4], kb[4]; { const int nb = 127 - 4 * (lane & 31); const f32x4 sa = *(const LAS f32x4*)(sl + 512 * c2 + 4 * lane), sb = *(const LAS f32x4*)(sl + 512 * c2 + 256 + 4 * lane);
#pragma unroll
              for (int e2 = 0; e2 < 4; ++e2) { ka[e2] = (f2ord(sa[e2]) & ~127) | (nb - e2); kb[e2] = (f2ord(sb[e2]) & ~127) | (nb - e2); } }
            PEER_CE(ka[0], ka[1]) PEER_CE(ka[2], ka[3]) PEER_CE(ka[0], ka[2]) PEER_CE(ka[1], ka[3]) PEER_CE(ka[1], ka[2])
            PEER_CE(kb[0], kb[1]) PEER_CE(kb[2], kb[3]) PEER_CE(kb[0], kb[2]) PEER_CE(kb[1], kb[3]) PEER_CE(kb[1], kb[2])
            int mineA = IMIN, mineB = IMIN;
#pragma unroll 1
            for (int it = 0; it < 16; ++it) {
                const int mA = half32_max_i(ka[0]), mB = half32_max_i(kb[0]);
                PEER_POP(ka, mA) PEER_POP(kb, mB)
                mineA = (lane & 31) == it ? mA : mineA; mineB = (lane & 31) == it ? mB : mineB;
            }
            if ((lane & 31) < 16) { kl[(4 * c2 + (lane >> 5)) * 16 + (lane & 31)] = mineA; kl[(4 * c2 + 2 + (lane >> 5)) * 16 + (lane & 31)] = mineB; }
        }
#undef PEER_CE
#undef PEER_POP
        LDS_WAIT();
#pragma unroll 1
        for (int h2 = 0; h2 < 4; ++h2) {
            int keyA, keyB;
            { const int hd = 2 * h2; const int ka = kl[(2 * hd) * 16 + ci], kb = kl[(2 * hd + 1) * 16 + cj];
              const float v = sl[(2 * hd) * 128 + 127 - (ka & 127)] + sl[(2 * hd + 1) * 128 + 127 - (kb & 127)]; keyA = cvalid ? ((f2ord(v) & ~255) | (255 - (ci * 16 + cj))) : IMIN; }
            { const int hd = 2 * h2 + 1; const int ka = kl[(2 * hd) * 16 + ci], kb = kl[(2 * hd + 1) * 16 + cj];
              const float v = sl[(2 * hd) * 128 + 127 - (ka & 127)] + sl[(2 * hd + 1) * 128 + 127 - (kb & 127)]; keyB = cvalid ? ((f2ord(v) & ~255) | (255 - (ci * 16 + cj))) : IMIN; }
            int mineA = IMIN, mineB = IMIN;
#pragma unroll 1
            for (int it = 0; it < 16; ++it) { const int mA = wave_max_fast_i(keyA), mB = wave_max_fast_i(keyB); keyA = keyA == mA ? IMIN : keyA; keyB = keyB == mB ? IMIN : keyB; mineA = lane == it ? mA : mineA; mineB = lane == it ? mB : mineB; }
#pragma unroll
            for (int q2 = 0; q2 < 2; ++q2) { const int hd = 2 * h2 + q2, mine = q2 ? mineB : mineA;
                const int fl = 255 - (mine & 255), wi = (fl >> 4) & 15, wj = fl & 15;
                const int k1 = kl[(2 * hd) * 16 + wi], k2 = kl[(2 * hd + 1) * 16 + wj];
                const int n1 = 127 - (k1 & 127), n2 = 127 - (k2 & 127);
                const float bv = sl[(2 * hd) * 128 + n1] + sl[(2 * hd + 1) * 128 + n2];
                const float bmax = __shfl(bv, 0);
                const float e = lane < 16 ? __expf((bv - bmax) * rstd2) : 0.f;
                const float es = wave_sum_fast(e);
                if (lane < 16) { exl[hd * 16 + lane] = n1 * 128 + n2; gtl[hd * 16 + lane] = e / es; } }
        }
        LDS_WAIT();
#if defined(PROBE_DUMP) && PROBE_DUMP == 3
        {
            float* orow = p.out + (size_t)t * D;
            for (int i = lane; i < 4096; i += 64) orow[i] = 0.f;
            orow[lane] = PROBE_DUMP_A * gtl[lane]; orow[64 + lane] = PROBE_DUMP_A * gtl[64 + lane];
            orow[128 + lane] = PROBE_DUMP_S * (float)exl[lane] * (1.0f / 16384.0f); orow[192 + lane] = PROBE_DUMP_S * (float)exl[64 + lane] * (1.0f / 16384.0f);
            if (lane == 0) orow[256] = rstd2;
            continue;
        }
#endif
        pg8::pg8_h2 oh[4][8]; v4u xq[3][2]; v4u xraw[4][2];
        { float xf[4][16];
#pragma unroll
          for (int c = 0; c < 4; ++c) { const v4u w0 = *(const v4u*)(X1B + (size_t)t * D + 1024 * c + 16 * lane), w1 = *(const v4u*)(X1B + (size_t)t * D + 1024 * c + 16 * lane + 8); xraw[c][0] = w0; xraw[c][1] = w1;
            xf[c][0] = bflo(w0.x); xf[c][1] = bfhi(w0.x); xf[c][2] = bflo(w0.y); xf[c][3] = bfhi(w0.y); xf[c][4] = bflo(w0.z); xf[c][5] = bfhi(w0.z); xf[c][6] = bflo(w0.w); xf[c][7] = bfhi(w0.w);
            xf[c][8] = bflo(w1.x); xf[c][9] = bfhi(w1.x); xf[c][10] = bflo(w1.y); xf[c][11] = bfhi(w1.y); xf[c][12] = bflo(w1.z); xf[c][13] = bfhi(w1.z); xf[c][14] = bflo(w1.w); xf[c][15] = bfhi(w1.w);
#pragma unroll
            for (int e = 0; e < 8; ++e) oh[c][e] = (pg8::pg8_h2){(_Float16)0.f, (_Float16)0.f}; }
          VM_WAIT();
#pragma unroll
          for (int c = 0; c < 4; ++c) { PIN(xraw[c][0]); PIN(xraw[c][1]); }
#define PEER_XQ(cc, d, b) { wq_ = __builtin_amdgcn_cvt_scalef32_pk_fp4_f32(wq_, clamp6(xf[cc][8 * d + 2 * b]), clamp6(xf[cc][8 * d + 2 * b + 1]), 1.0f, b); }
#define PEER_XR(cc, d, b) { const f32x2 dq_ = __builtin_amdgcn_cvt_scalef32_pk_f32_fp4(wq_, 1.0f, b); xf[cc][8 * d + 2 * b] = (xf[cc][8 * d + 2 * b] - dq_.x) * 8.0f; xf[cc][8 * d + 2 * b + 1] = (xf[cc][8 * d + 2 * b + 1] - dq_.y) * 8.0f; }
#pragma unroll
          for (int tq = 0; tq < 3; ++tq)
#pragma unroll
              for (int cc = 0; cc < 4; ++cc)
#pragma unroll
                  for (int d = 0; d < 2; ++d) { unsigned wq_ = 0;
                      PEER_XQ(cc, d, 0) PEER_XQ(cc, d, 1) PEER_XQ(cc, d, 2) PEER_XQ(cc, d, 3)
                      PEER_XR(cc, d, 0) PEER_XR(cc, d, 1) PEER_XR(cc, d, 2) PEER_XR(cc, d, 3)
                      xq[tq][cc >> 1][2 * (cc & 1) + d] = wq_; }
#undef PEER_XQ
#undef PEER_XR
        }
        const int lane16 = 16 * lane;
        const bool ondiag = ((lane & 15) >> 2) == (lane >> 4); const int drow = lane & 3;
        float dm0 = (ondiag && drow == 0) ? 1.0f : 0.0f, dm1 = (ondiag && drow == 1) ? 1.0f : 0.0f, dm2 = (ondiag && drow == 2) ? 1.0f : 0.0f, dm3 = (ondiag && drow == 3) ? 1.0f : 0.0f;
        asm volatile("" : "+v"(dm0), "+v"(dm1), "+v"(dm2), "+v"(dm3));
#define PEER_FILL(kk) do { const int eo_ = __builtin_amdgcn_readfirstlane(exl[(kk)]) * PEER_ROWB;     \
        LAS unsigned char* sl_ = wl + ((kk) & 3) * 4096; \
        __builtin_amdgcn_raw_ptr_buffer_load_lds(rsU, (LAS void*)(sl_), 16, lane16, eo_, 0, 0); __builtin_amdgcn_raw_ptr_buffer_load_lds(rsV, (LAS void*)(sl_ + 2048), 16, lane16, eo_, 0, 0); \
        __builtin_amdgcn_raw_ptr_buffer_load_lds(rsU, (LAS void*)(sl_ + 1024), 16, lane16, eo_ + 1024, 0, 0); __builtin_amdgcn_raw_ptr_buffer_load_lds(rsV, (LAS void*)(sl_ + 3072), 16, lane16, eo_ + 1024, 0, 0); } while (0)
#define PEER_V(VB, W2, q, dd, b) oh[2 * q + (dd >> 1)][4 * (dd & 1) + b] = __builtin_amdgcn_cvt_scalef32_pk_f16_fp4(VB[q][dd], 1.0f, b) * W2 + oh[2 * q + (dd >> 1)][4 * (dd & 1) + b]
#define PEER_ALLV(VB, W2) PEER_V(VB, W2, 0, 0, 0); PEER_V(VB, W2, 0, 0, 1); PEER_V(VB, W2, 0, 0, 2); PEER_V(VB, W2, 0, 0, 3); PEER_V(VB, W2, 0, 1, 0); PEER_V(VB, W2, 0, 1, 1); PEER_V(VB, W2, 0, 1, 2); PEER_V(VB, W2, 0, 1, 3); \
                          PEER_V(VB, W2, 0, 2, 0); PEER_V(VB, W2, 0, 2, 1); PEER_V(VB, W2, 0, 2, 2); PEER_V(VB, W2, 0, 2, 3); PEER_V(VB, W2, 0, 3, 0); PEER_V(VB, W2, 0, 3, 1); PEER_V(VB, W2, 0, 3, 2); PEER_V(VB, W2, 0, 3, 3); \
                          PEER_V(VB, W2, 1, 0, 0); PEER_V(VB, W2, 1, 0, 1); PEER_V(VB, W2, 1, 0, 2); PEER_V(VB, W2, 1, 0, 3); PEER_V(VB, W2, 1, 1, 0); PEER_V(VB, W2, 1, 1, 1); PEER_V(VB, W2, 1, 1, 2); PEER_V(VB, W2, 1, 1, 3); \
                          PEER_V(VB, W2, 1, 2, 0); PEER_V(VB, W2, 1, 2, 1); PEER_V(VB, W2, 1, 2, 2); PEER_V(VB, W2, 1, 2, 3); PEER_V(VB, W2, 1, 3, 0); PEER_V(VB, W2, 1, 3, 1); PEER_V(VB, W2, 1, 3, 2); PEER_V(VB, W2, 1, 3, 3)
#define PEER_DOT(UB, DG) { const pg8::i32x8 ua0 = {(int)UB[0].x, (int)UB[0].y, (int)UB[0].z, (int)UB[0].w, 0, 0, 0, 0}, ua1 = {(int)UB[1].x, (int)UB[1].y, (int)UB[1].z, (int)UB[1].w, 0, 0, 0, 0}; \
              _Pragma("unroll") for (int tq = 0; tq < 3; ++tq) { const int sc = tq == 0 ? 0x7f7f7f7f : (tq == 1 ? 0x7c7c7c7c : 0x79797979); \
                DG = __builtin_amdgcn_mfma_scale_f32_16x16x128_f8f6f4(ua0, (pg8::i32x8){(int)xq[tq][0].x, (int)xq[tq][0].y, (int)xq[tq][0].z, (int)xq[tq][0].w, 0, 0, 0, 0}, DG, 4, 4, 0, 0x7f7f7f7f, 0, sc); \
                DG = __builtin_amdgcn_mfma_scale_f32_16x16x128_f8f6f4(ua1, (pg8::i32x8){(int)xq[tq][1].x, (int)xq[tq][1].y, (int)xq[tq][1].z, (int)xq[tq][1].w, 0, 0, 0, 0}, DG, 4, 4, 0, 0x7f7f7f7f, 0, sc); } }
        const bool oddl = (lane & 1) != 0;
        if (pmode != 2) { PEER_FILL(0); PEER_FILL(1); PEER_FILL(2); PEER_FILL(3); }
#pragma unroll 1
        for (int k = 0; k < (PROBE_SKIP_PEER ? 0 : 128); k += 2) {
            if (pmode != 2) { if (k < 126) asm volatile("s_waitcnt vmcnt(8)" ::: "memory"); else asm volatile("s_waitcnt vmcnt(0)" ::: "memory"); }
            const LAS unsigned char* spA = wl + (k & 3) * 4096 + 16 * lane; const LAS unsigned char* spB = wl + ((k + 1) & 3) * 4096 + 16 * lane;
            v4u ubA[2], vbA[2], ubB[2], vbB[2];
#pragma unroll
            for (int c = 0; c < 2; ++c) { ubA[c] = *(const LAS v4u*)(spA + 1024 * c); ubB[c] = *(const LAS v4u*)(spB + 1024 * c); }
#pragma unroll
            for (int c = 0; c < 2; ++c) { vbA[c] = *(const LAS v4u*)(spA + 2048 + 1024 * c); vbB[c] = *(const LAS v4u*)(spB + 2048 + 1024 * c); }
            const float gate = gtl[k + (lane & 1)];
            LDS_WAIT();
            asm volatile("" : "+v"(vbA[0]), "+v"(vbA[1]), "+v"(vbB[0]), "+v"(vbB[1]));
            if (pmode != 2 && k < 124) { PEER_FILL(k + 4); PEER_FILL(k + 5); }
            f32x4 dgA = {0.f, 0.f, 0.f, 0.f}, dgB = {0.f, 0.f, 0.f, 0.f};
            PEER_DOT(ubA, dgA) PEER_DOT(ubB, dgB)
            asm volatile("" : "+v"(dgA), "+v"(dgB) : "v"(ubA[0]), "v"(ubA[1]), "v"(ubB[0]), "v"(ubB[1]));
            const float pA = dgA[0] * dm0 + dgA[1] * dm1 + dgA[2] * dm2 + dgA[3] * dm3, pB = dgB[0] * dm0 + dgB[1] * dm1 + dgB[2] * dm2 + dgB[3] * dm3;
            float r = (oddl ? pB : pA) + __int_as_float(DPP_I(__float_as_int(oddl ? pA : pB), 0xB1));
            r += __int_as_float(DPP_I(__float_as_int(r), 0x4E)); r += __int_as_float(DPP_I(__float_as_int(r), 0x124)); r += __int_as_float(DPP_I(__float_as_int(r), 0x128));
            { const int v = __float_as_int(r); const auto s16 = __builtin_amdgcn_permlane16_swap((unsigned)v, (unsigned)v, false, false); r = __uint_as_float(s16[0]) + __uint_as_float(s16[1]); }
            { const int v = __float_as_int(r); const auto s32 = __builtin_amdgcn_permlane32_swap((unsigned)v, (unsigned)v, false, false); r = __uint_as_float(s32[0]) + __uint_as_float(s32[1]); }
            const float wgt = PROBE_SP * gate * pg8::gelu_tanh(r * (rstd2 * (1.0f / PEER_SU))) * (1.0f / PEER_SV);
            const pg8::pg8_h2 w2 = {(_Float16)wgt, (_Float16)wgt}; const int w2i = (int)__builtin_bit_cast(unsigned, w2);
            const pg8::pg8_h2 w2A = __builtin_bit_cast(pg8::pg8_h2, (unsigned)__builtin_amdgcn_update_dpp(0, w2i, 0xA0, 0xF, 0xF, true)), w2B = __builtin_bit_cast(pg8::pg8_h2, (unsigned)__builtin_amdgcn_update_dpp(0, w2i, 0xF5, 0xF, 0xF, true));
            PEER_ALLV(vbA, w2A);
            PEER_ALLV(vbB, w2B);
        }
        asm volatile("s_waitcnt vmcnt(0)" ::: "memory");
#undef PEER_FILL
#undef PEER_V
#undef PEER_ALLV
#undef PEER_DOT
        float ov[4][16];
#pragma unroll
        for (int c = 0; c < 4; ++c)
#pragma unroll
            for (int e = 0; e < 8; ++e) { ov[c][2 * e] = (float)oh[c][e].x; ov[c][2 * e + 1] = (float)oh[c][e].y; }
        float* orow = p.out + (size_t)t * D; float sq = 0.f;
#pragma unroll
        for (int c = 0; c < 4; ++c) { f32x4 a[4];
            a[0] = (f32x4){bflo(xraw[c][0].x), bfhi(xraw[c][0].x), bflo(xraw[c][0].y), bfhi(xraw[c][0].y)}; a[1] = (f32x4){bflo(xraw[c][0].z), bfhi(xraw[c][0].z), bflo(xraw[c][0].w), bfhi(xraw[c][0].w)};
            a[2] = (f32x4){bflo(xraw[c][1].x), bfhi(xraw[c][1].x), bflo(xraw[c][1].y), bfhi(xraw[c][1].y)}; a[3] = (f32x4){bflo(xraw[c][1].z), bfhi(xraw[c][1].z), bflo(xraw[c][1].w), bfhi(xraw[c][1].w)};
#pragma unroll
            for (int j = 0; j < 4; ++j)
#pragma unroll
                for (int e = 0; e < 4; ++e) { ov[c][4 * j + e] += a[j][e]; sq += ov[c][4 * j + e] * ov[c][4 * j + e]; } }
        sq = wave_sum(sq);
        const float rf = rsqrtf(sq * (1.0f / 4096.0f) + EPS);
#pragma unroll
        for (int c = 0; c < 4; ++c) { f32x4 g[4];
#pragma unroll
            for (int j = 0; j < 4; ++j) g[j] = *(const f32x4*)(p.norm_final_g + 1024 * c + 16 * lane + 4 * j);
#pragma unroll
            for (int j = 0; j < 4; ++j) PIN(g[j]);
#pragma unroll
            for (int j = 0; j < 4; ++j) if (!dry || rf == -1.0f) *(f32x4*)(orow + 1024 * c + 16 * lane + 4 * j) = (f32x4){ov[c][4 * j] * rf * g[j][0], ov[c][4 * j + 1] * rf * g[j][1], ov[c][4 * j + 2] * rf * g[j][2], ov[c][4 * j + 3] * rf * g[j][3]}; }
    }
}

__global__ void __launch_bounds__(NWAVES * 64, 2) fwd(Params p) {
    extern __shared__ __attribute__((aligned(16))) unsigned char lds_raw[];
    LAS unsigned char* lds = (LAS unsigned char*)lds_raw;
    const int tid = threadIdx.x, lane = tid & 63, wave = __builtin_amdgcn_readfirstlane(tid >> 6);
    unsigned char* ws = p.ws;
    if (tid < 64) ((LAS unsigned*)(lds + LDS_MISC))[tid] = 0u;
#if defined(PROBE_FENCES)
    __builtin_amdgcn_fence(__ATOMIC_ACQUIRE, PROBE_SCOPE); asm volatile("s_waitcnt vmcnt(0)" ::: "memory");
#endif
    __syncthreads();
    const int lo = p.ph_lo, hi = p.ph_hi;
    XcdBarrier bar; bar.bar = (unsigned*)(ws + WS_CTL) + CW_BAR + p.li * XCD_BAR_WORDS; bar.x = 0; bar.st = nullptr;
    if (hi - lo > 1) bar = xcd_barrier_post((unsigned*)(ws + WS_CTL) + CW_BAR + p.li * XCD_BAR_WORDS, (volatile LAS unsigned*)(lds + LDS_MISC) + 8);
#define IN(k) (lo <= (k) && (k) < hi)
#define SEAM(k) do { if (IN(k) && IN((k) + 1)) xcd_barrier(bar); } while (0)
    const int G = gridDim.x;

    if (IN(0)) { p0_prologue(p, lds, tid, lane, wave); if (PROBE_DUP == 0) { xcd_barrier(bar); p0_prologue(p, lds, tid, lane, wave); } }
    SEAM(0);
    if (IN(1)) {
        const pg8::EpiIn E0{(const float*)(ws + WS_SS1), (const float*)(ws + WS_COS), (const float*)(ws + WS_SIN), p.b_gate, (float*)(ws + CB_KACC), 0, 1.0f, (bf16*)(ws + WS_Q), (bf16*)(ws + WS_G)};
        const pg8::EpiIn E1{(const float*)(ws + WS_SS1), (const float*)(ws + WS_COS), (const float*)(ws + WS_SIN), p.b_gate, (float*)(ws + CB_KACC), 1, 1.0f / (S_X * S_W1), (bf16*)(ws + WS_Q), (bf16*)(ws + WS_G)};
        static_assert(WS_K - WS_Q == (size_t)T * 2048 * 2 && WS_V - WS_K == WS_K - WS_Q && WS_U - WS_V == WS_K - WS_Q && WS_GV - WS_U == WS_K - WS_Q, "q|k|v|u|gv contiguous");
#if ZUZV_FP8
        { const pg8::EpiIn E2{(const float*)(ws + WS_SS1), (const float*)(ws + WS_COS), (const float*)(ws + WS_SIN), p.b_gate, (float*)(ws + CB_KACC), 2, 1.0f / (S_X * S_W1), (bf16*)(ws + WS_Q), (bf16*)(ws + WS_G)};
          pg8::Gemm g{(const bf16*)(ws + WS_XB8), (const bf16*)(ws + WS_W18), T, N1, D}; pg8::StaticOrder S; S.init(T, N1, G, (int)blockIdx.x);
          pg8::gemm_phase<pg8::EpiIn, pg8::StaticOrder, true, true, true>(lds, g, S, E2); (void)E0; (void)E1; }
#if PROBE_DUP == 11
          { xcd_barrier(bar); const pg8::EpiNull EN{};
            pg8::Gemm g{(const bf16*)(ws + WS_XB8), (const bf16*)(ws + WS_W18), T, N1, D}; pg8::StaticOrder S; S.init(T, N1, G, (int)blockIdx.x);
            pg8::gemm_phase<pg8::EpiNull, pg8::StaticOrder, true, true, true>(lds, g, S, EN); }
#endif
#if PROBE_DUP == 1
          { xcd_barrier(bar); const pg8::EpiIn E2{(const float*)(ws + WS_SS1), (const float*)(ws + WS_COS), (const float*)(ws + WS_SIN), p.b_gate, (float*)(ws + CB_KACC), 2, 1.0f / (S_X * S_W1), (bf16*)(ws + WS_Q), (bf16*)(ws + WS_G)};
            pg8::Gemm g{(const bf16*)(ws + WS_XB8), (const bf16*)(ws + WS_W18), T, N1, D}; pg8::StaticOrder S; S.init(T, N1, G, (int)blockIdx.x);
            pg8::gemm_phase<pg8::EpiIn, pg8::StaticOrder, true, true, true>(lds, g, S, E2); }
#endif
#else
        { pg8::Gemm g{(const bf16*)(ws + WS_XB), (const bf16*)(ws + WS_W1Z), T, 4096, D}; pg8::StaticOrder S; S.init(T, 4096, G, (int)blockIdx.x);
          pg8::gemm_phase<pg8::EpiIn, pg8::StaticOrder, true, true>(lds, g, S, E0); }
        { pg8::Gemm g{(const bf16*)(ws + WS_XB8), (const bf16*)(ws + WS_W18), T, 14336, D}; pg8::StaticOrder S; S.init(T, 14336, G, (int)blockIdx.x);
          pg8::gemm_phase<pg8::EpiIn, pg8::StaticOrder, true, true, true>(lds, g, S, E1); }
#endif
    }
    SEAM(1);
#if defined(PROBE_GATECHK)
    if (IN(2)) {
        float* accum = (float*)(ws + 147456);
        const float* ss1 = (const float*)(ws + WS_SS1); const bf16* Gm = (const bf16*)(ws + WS_G);
        const int gw2 = blockIdx.x * NWAVES + wave, NGW2 = gridDim.x * NWAVES; float num = 0.f, den = 0.f;
        for (int task = gw2; task < 128 * 128; task += NGW2) { const int t = PROBE_T0 + PROBE_TSTRIDE * (task >> 7), n = (task & 127) * 64 + lane;
            float s = 0.f; for (int k = 0; k < D; ++k) s += p.x[(size_t)t * D + k] * p.norm_mix_g[k] * p.w_gate[(size_t)k * GWD + n];
            const float rs = rsqrtf(ss1[t] * (1.0f / 4096.0f) + EPS); const float ref = 1.0f / (1.0f + __expf(-(s * rs + p.b_gate[n])));
            const float mine = __uint_as_float((unsigned)Gm[(size_t)t * GWD + (n ^ PROBE_XOR)] << 16);
            num += (mine - ref) * (mine - ref); den += ref * ref; }
        num = wave_sum(num); den = wave_sum(den);
        if (lane == 0) { atomicAdd(accum, num); atomicAdd(accum + 1, den); }
        xcd_barrier(bar);
        const float c = PROBE_K * sqrtf(__hip_atomic_load(accum, __ATOMIC_RELAXED, __HIP_MEMORY_SCOPE_AGENT) / __hip_atomic_load(accum + 1, __ATOMIC_RELAXED, __HIP_MEMORY_SCOPE_AGENT));
        for (size_t i = (size_t)blockIdx.x * 512 + tid; i < (size_t)T * D; i += (size_t)gridDim.x * 512) p.out[i] = c;
        return;
    }
#endif
    if (IN(2)) {
        for (int u = blockIdx.x; u < 1024; u += 4 * G) moba_select_multi<4>(p, u, G, lane, wave);
        for (int u = blockIdx.x; u < 2048; u += G) sgu_unit(p, lds, u >> 4, u & 15, tid, lane, wave);
        if (PROBE_DUP == 2) { xcd_barrier(bar); for (int u = blockIdx.x; u < 2048; u += G) sgu_unit(p, lds, u >> 4, u & 15, tid, lane, wave); }
    }
    SEAM(2);
    if (IN(3)) { attn_phase(p, lds, tid, lane, wave); if (PROBE_DUP == 3) { xcd_barrier(bar); attn_phase(p, lds, tid, lane, wave); } }
    SEAM(3);
    if (IN(4)) { attn_combine(p, lane, wave); peer_tables(p, tid); if (PROBE_DUP == 4) { xcd_barrier(bar); attn_combine(p, lane, wave); peer_tables(p, tid); } }
    SEAM(4);
    if (IN(5)) {
        { pg8::Gemm g{(const bf16*)(ws + WS_AO8), (const bf16*)(ws + WS_WAP), T, D, AW}; pg8::StaticOrder S; S.init(T, D, G, (int)blockIdx.x);
          pg8::EpiMix<0> E{(const bf16*)(ws + WS_G), (bf16*)(ws + WS_MIX), (bf16*)(ws + WS_X1B), 1.0f / (S_AO * S_WAP), 1.0f};
          pg8::gemm_phase<pg8::EpiMix<0>, pg8::StaticOrder, true, true, true>(lds, g, S, E); }
        { pg8::Gemm g{(const bf16*)(ws + WS_SO), (const bf16*)(ws + WS_WSP), T, D, AW}; pg8::StaticOrder S; S.init(T, D, G, (int)blockIdx.x);
          pg8::EpiMix<1> E{(const bf16*)(ws + WS_G), (bf16*)(ws + WS_MIX), (bf16*)(ws + WS_X1B), SGU_FP8 ? 1.0f / (S_SO * S_WSP) : 1.0f, S_MIX};
          pg8::gemm_phase<pg8::EpiMix<1>, pg8::StaticOrder, true, true, SGU_FP8 != 0>(lds, g, S, E); }
    #if PROBE_DUP == 567 || PROBE_DUP == 5
        xcd_barrier(bar);
        {
        { pg8::Gemm g{(const bf16*)(ws + WS_AO8), (const bf16*)(ws + WS_WAP), T, D, AW}; pg8::StaticOrder S; S.init(T, D, G, (int)blockIdx.x);
          pg8::EpiMix<0> E{(const bf16*)(ws + WS_G), (bf16*)(ws + WS_MIX), (bf16*)(ws + WS_X1B), 1.0f / (S_AO * S_WAP), 1.0f};
          pg8::gemm_phase<pg8::EpiMix<0>, pg8::StaticOrder, true, true, true>(lds, g, S, E); }
        { pg8::Gemm g{(const bf16*)(ws + WS_SO), (const bf16*)(ws + WS_WSP), T, D, AW}; pg8::StaticOrder S; S.init(T, D, G, (int)blockIdx.x);
          pg8::EpiMix<1> E{(const bf16*)(ws + WS_G), (bf16*)(ws + WS_MIX), (bf16*)(ws + WS_X1B), SGU_FP8 ? 1.0f / (S_SO * S_WSP) : 1.0f, S_MIX};
          pg8::gemm_phase<pg8::EpiMix<1>, pg8::StaticOrder, true, true, SGU_FP8 != 0>(lds, g, S, E); }
    }
#endif
    }
    SEAM(5);
#ifndef PROBE_SKIP_P6
#define PROBE_SKIP_P6 0
#endif
    if (IN(6) && !PROBE_SKIP_P6) {
        pg8::Gemm g{(const bf16*)(ws + WS_MIX), (const bf16*)(ws + WS_WO), T, D, D}; pg8::StaticOrder S; S.init(T, D, G, (int)blockIdx.x);
        pg8::EpiWo E{(const float*)(ws + WS_XBF), p.out, (bf16*)(ws + WS_X1B), (float*)(ws + WS_SS2), 1.0f / (S_MIX * S_WO)};
        #ifndef PROBE_P6_ALIGN
#define PROBE_P6_ALIGN true
#endif
#ifndef PROBE_P6_SP2
#define PROBE_P6_SP2 true
#endif
        pg8::gemm_phase<pg8::EpiWo, pg8::StaticOrder, false, true, true>(lds, g, S, E);
    #if PROBE_DUP == 567 || PROBE_DUP == 6
        xcd_barrier(bar);
        {
        pg8::Gemm g{(const bf16*)(ws + WS_MIX), (const bf16*)(ws + WS_WO), T, D, D}; pg8::StaticOrder S; S.init(T, D, G, (int)blockIdx.x);
        pg8::EpiWo E{(const float*)(ws + WS_XBF), p.out, (bf16*)(ws + WS_X1B), (float*)(ws + WS_SS2), 1.0f / (S_MIX * S_WO)};
        #ifndef PROBE_P6_ALIGN
#define PROBE_P6_ALIGN true
#endif
#ifndef PROBE_P6_SP2
#define PROBE_P6_SP2 true
#endif
        pg8::gemm_phase<pg8::EpiWo, pg8::StaticOrder, false, true, true>(lds, g, S, E);
    }
#endif
    }
    SEAM(6);
#if defined(PROBE_DUMP) && PROBE_DUMP == 8
    if (IN(PROBE_AT)) {
        const int gw2 = blockIdx.x * NWAVES + wave, NGW2 = gridDim.x * NWAVES;
        for (int t = gw2; t < T; t += NGW2) { const bf16* Ap = (const bf16*)(ws + WS_MIX) + (size_t)t * 4096; float* orow = p.out + (size_t)t * D;
            for (int i = lane; i < 4096; i += 64) orow[i] = (float)(((unsigned)Ap[i] * 2654435761u) >> 16) * (1.0f / 65536.0f); }
        return;
    }
    if (IN(8) && PROBE_AT != 8) return;
#endif
    if (IN(7)) {
        #ifndef PROBE_P7_A
#define PROBE_P7_A WS_X1B
#endif
#ifndef PROBE_P7_B
#define PROBE_P7_B WS_W2
#endif
        pg8::Gemm g{(const bf16*)(ws + PROBE_P7_A), (const bf16*)(ws + PROBE_P7_B), T, 2048, D}; pg8::StaticOrder S; S.init(T, 2048, G, (int)blockIdx.x);
        pg8::EpiS E{(float*)(ws + WS_S)};
        pg8::gemm_phase<pg8::EpiS, pg8::StaticOrder, true, true>(lds, g, S, E);
    #if PROBE_DUP == 567 || PROBE_DUP == 7
        xcd_barrier(bar);
        {
        #ifndef PROBE_P7_A
#define PROBE_P7_A WS_X1B
#endif
#ifndef PROBE_P7_B
#define PROBE_P7_B WS_W2
#endif
        pg8::Gemm g{(const bf16*)(ws + PROBE_P7_A), (const bf16*)(ws + PROBE_P7_B), T, 2048, D}; pg8::StaticOrder S; S.init(T, 2048, G, (int)blockIdx.x);
        pg8::EpiS E{(float*)(ws + WS_S)};
        pg8::gemm_phase<pg8::EpiS, pg8::StaticOrder, true, true>(lds, g, S, E);
    }
#endif
    }
    SEAM(7);
#if 0
#else
    if (IN(8)) { if (PROBE_DUP == 8) { peer_phase(p, lds, lane, wave, true, PROBE_PMODE); xcd_barrier(bar); } peer_phase(p, lds, lane, wave); }
#endif
#if defined(PROBE_FENCES)
    asm volatile("s_waitcnt vmcnt(0)" ::: "memory"); __syncthreads();
    if (tid == 0) { __builtin_amdgcn_fence(__ATOMIC_RELEASE, PROBE_SCOPE); asm volatile("s_waitcnt vmcnt(0)" ::: "memory"); }
#endif
#undef IN
#undef SEAM
}

extern "C" void kernel_launch(void* const* d_in, const int* in_sizes, int n_in, void* d_out, int out_size, void* d_ws, size_t ws_size, hipStream_t stream) {
    static int grid = 0;
    if (grid == 0) {
        if (n_in != 17 || out_size != T * D || ws_size < WS_END) { fprintf(stderr, "kernel_launch: unexpected shapes (n_in %d, out %d, ws %zu)\n", n_in, out_size, ws_size); grid = -1; return; }
        int dev = 0, cus = 0, per_cu = 0;
        if (hipGetDevice(&dev) != hipSuccess || hipDeviceGetAttribute(&cus, hipDeviceAttributeMultiprocessorCount, dev) != hipSuccess) { grid = -1; return; }
        if (hipFuncSetAttribute((const void*)fwd, hipFuncAttributeMaxDynamicSharedMemorySize, LDS_BYTES) != hipSuccess) { fprintf(stderr, "kernel_launch: hipFuncSetAttribute failed\n"); grid = -1; return; }
        if (hipOccupancyMaxActiveBlocksPerMultiprocessor(&per_cu, (const void*)fwd, NWAVES * 64, LDS_BYTES) != hipSuccess || per_cu < 1) { fprintf(stderr, "kernel_launch: occupancy query says %d\n", per_cu); (void)hipGetLastError(); per_cu = 1; }
        grid = cus;
    }
    if (grid < 0) return;
    (void)hipMemsetAsync((char*)d_ws + WS_CTL, 0, CTL_ZERO_BYTES, stream);
    Params a{};
    a.x = (const float*)d_in[0]; a.norm_mix_g = (const float*)d_in[1]; a.w_in = (const float*)d_in[2]; a.w_attn_proj = (const float*)d_in[3]; a.sgu_norm_g = (const float*)d_in[4];
    a.sgu_w = (const float*)d_in[5]; a.sgu_b = (const float*)d_in[6]; a.w_sgu_proj = (const float*)d_in[7]; a.w_gate = (const float*)d_in[8]; a.b_gate = (const float*)d_in[9];
    a.w_o = (const float*)d_in[10]; a.norm_ffn_g = (const float*)d_in[11]; a.peer_wq = (const float*)d_in[12]; a.peer_subkeys = (const float*)d_in[13]; a.peer_u = (const float*)d_in[14];
    a.peer_v = (const float*)d_in[15]; a.norm_final_g = (const float*)d_in[16];
    a.out = (float*)d_out; a.ws = (unsigned char*)d_ws;
    for (int li = 0; li < N_LAUNCH; ++li) {
        a.ph_lo = (N_LAUNCH == 1) ? 0 : li; a.ph_hi = (N_LAUNCH == 1) ? NPHASE : li + 1; a.li = li; a.pad = 0;
        hipLaunchKernelGGL(fwd, dim3(grid), dim3(NWAVES * 64), LDS_BYTES, stream, a);
#if defined(PROBE_REPEAT_P6)
        if (N_LAUNCH != 1 && li == 6) hipLaunchKernelGGL(fwd, dim3(grid), dim3(NWAVES * 64), LDS_BYTES, stream, a);
#endif
        const hipError_t le = hipPeekAtLastError();
        if (le != hipSuccess) { fprintf(stderr, "kernel_launch: launch %d failed: %s\n", li, hipGetErrorName(le)); break; }
    }
}
```

```cpp
#include <hip/hip_runtime.h>
#include <cstdio>
#include <cstdint>
namespace pg8 {
#define PG8_LAS __attribute__((address_space(3)))
typedef unsigned short bf16_t;
typedef short bf16x8 __attribute__((ext_vector_type(8)));
typedef float f32x4 __attribute__((ext_vector_type(4)));
typedef unsigned u32x4 __attribute__((ext_vector_type(4)));
constexpr int BM = 256, BK = 64, HALF = 128, HTB = HALF * BK * 2  , STAGE_BYTES = 8 * HTB, NXCD = 8, WGM = 8;

__host__ __device__ __forceinline__ int lds_byte(int r, int c) { const int st = (r >> 4) * 2 + (c >> 5), rr = r & 15, cc = c & 31, ob = rr * 64 + cc * 2; return st * 1024 + (ob ^ (((ob >> 9) & 1) << 5)); }
__host__ __device__ __forceinline__ void stage_rc(int b, int& R, int& C) { const int st = b / 1024, sb = b % 1024, swz = sb ^ (((sb >> 9) & 1) << 5); R = (st >> 1) * 16 + swz / 64; C = (st & 1) * 32 + (swz % 64) / 2; }
__host__ __device__ __forceinline__ int perm32(int rho) { const int n = rho >> 4, i = rho & 15; return 8 * (i >> 2) + 4 * n + (i & 3); }

struct Unit { int pm, pn; };
struct Gemm { const bf16_t* A; const bf16_t* Bt; int M, N, K; };

struct StaticOrder {
    int nM, nN, nwg, G, c;
    __host__ __device__ void init(int M, int N, int G_, int c_) { nM = M / BM; nN = N / BM; nwg = nM * nN; G = G_; c = c_; }
    __host__ __device__ bool next(int i, Unit& u) const {
        const long L = (long)i * G + c; if (L >= nwg) return false;
        int wgid = (int)L; { const int q = nwg / NXCD, r = nwg % NXCD, xcd = wgid % NXCD, off = wgid / NXCD; wgid = (xcd < r ? xcd * (q + 1) : r * (q + 1) + (xcd - r) * q) + off; }
        const int nig = WGM * nN, gid = wgid / nig, fm = gid * WGM, gsz = (nM - fm) < WGM ? (nM - fm) : WGM;
        u.pm = fm + ((wgid % nig) % gsz); u.pn = (wgid % nig) / gsz; return true;
    }
    __device__ __forceinline__ void a_ready(const Unit&) const {}
    __device__ __forceinline__ void done(const Unit&) const {}
};
typedef float f32x2 __attribute__((ext_vector_type(2)));
typedef __bf16 pg8_bf16x2 __attribute__((ext_vector_type(2)));
typedef _Float16 pg8_h2 __attribute__((ext_vector_type(2)));
__device__ __forceinline__ unsigned cvt_pk_bf16(float lo, float hi) { const f32x2 v = {lo, hi}; const pg8_bf16x2 r = __builtin_convertvector(v, pg8_bf16x2); return __builtin_bit_cast(unsigned, r); }

#define PG8_EPI_WAIT() asm volatile("s_waitcnt vmcnt(0)" ::: "memory")
#define PG8_PIN(v) asm volatile("s_waitcnt vmcnt(0)" : "+v"(v) : : "memory")
typedef unsigned u32x2 __attribute__((ext_vector_type(2)));
__device__ __forceinline__ unsigned pg8_pk4_fp8(f32x4 a) { int w = 0;
    w = __builtin_amdgcn_cvt_pk_fp8_f32(fminf(fmaxf(a[0], -448.f), 448.f), fminf(fmaxf(a[1], -448.f), 448.f), w, false); w = __builtin_amdgcn_cvt_pk_fp8_f32(fminf(fmaxf(a[2], -448.f), 448.f), fminf(fmaxf(a[3], -448.f), 448.f), w, true); return (unsigned)w; }
__device__ __forceinline__ float gelu_tanh(float x) {
    const float u = x * (0.7978845608f + 0.0356774081f * x * x);
    const float e = __builtin_amdgcn_exp2f(u * -2.8853900818f);
    return x * __builtin_amdgcn_rcpf(1.0f + e);
}
__device__ __forceinline__ float sigm(float z) { return __builtin_amdgcn_rcpf(1.0f + __builtin_amdgcn_exp2f(z * -1.4426950409f)); }
__device__ __forceinline__ float bf_lo(unsigned w) { return __uint_as_float(w << 16); }
__device__ __forceinline__ float bf_hi(unsigned w) { return __uint_as_float(w & 0xffff0000u); }

struct EpiIn {
    static constexpr bool PERM = true, AFTER_DRAIN = false;
    const float* ss1; const float* cosT; const float* sinT; const float* bgate; float* kacc;
    int mode; float descale;
    bf16_t *QKVUG, *G;
    __device__ __forceinline__ void operator()(const f32x4 (&acc)[2][2][4][2], const Unit& u, int wr, int wc, int fr, int fq) const {
        asm volatile("" : "+v"(fr), "+v"(fq));
        const int colt = mode == 2 ? u.pn * BM : (mode == 0 ? 6144 + u.pn * BM : (u.pn < 24 ? u.pn * BM : 10240 + (u.pn - 24) * BM)), reg = colt >> 11;
        const int row0 = u.pm * BM + wr * 64 + fr, cw = wc * 32 + 8 * fq;
        float rs[2][4];
#pragma unroll
        for (int ai = 0; ai < 2; ++ai)
#pragma unroll
            for (int m = 0; m < 4; ++m) rs[ai][m] = ss1[row0 + ai * HALF + m * 16];
#define PG8_RS_READY() do { PG8_EPI_WAIT(); _Pragma("unroll") for (int ai = 0; ai < 2; ++ai) _Pragma("unroll") for (int m = 0; m < 4; ++m) { PG8_PIN(rs[ai][m]); rs[ai][m] = rsqrtf(rs[ai][m] * (1.0f / 4096.0f) + 1e-6f) * descale; } } while (0)
        if (reg <= 1) {
            bf16_t* dst = QKVUG + (size_t)reg * ((size_t)16384 * 2048); const int colh = colt - reg * 2048, g4 = (wc * 4 + fq) * 4;
            f32x4 ks[2][2];
#pragma unroll
            for (int bj = 0; bj < 2; ++bj) { ks[bj][0] = (f32x4){0.f, 0.f, 0.f, 0.f}; ks[bj][1] = (f32x4){0.f, 0.f, 0.f, 0.f}; }
#pragma unroll
            for (int ai = 0; ai < 2; ++ai) {
                f32x4 cc[4], sn[4];
#pragma unroll
                for (int mm = 0; mm < 4; ++mm) { const int row = row0 + ai * HALF + mm * 16; cc[mm] = *(const f32x4*)(cosT + (size_t)row * 64 + g4); sn[mm] = *(const f32x4*)(sinT + (size_t)row * 64 + g4); }
                if (ai == 0) PG8_RS_READY(); else PG8_EPI_WAIT();
#pragma unroll
                for (int mm = 0; mm < 4; ++mm) { PG8_PIN(cc[mm]); PG8_PIN(sn[mm]); }
#pragma unroll
                for (int m2 = 0; m2 < 4; m2 += 2)
#pragma unroll
                    for (int bj = 0; bj < 2; ++bj) { u32x2 wa, wb;
#pragma unroll
                        for (int mq = 0; mq < 2; ++mq) { const int m = m2 + mq; const float r = rs[ai][m]; const f32x4 c4 = cc[m], s4 = sn[m];
                            const f32x4 x1 = acc[ai][bj][m][0] * r, x2 = acc[ai][bj][m][1] * r;
                            const f32x4 o1 = x1 * c4 - x2 * s4, o2 = x2 * c4 + x1 * s4;
                            u32x2 w; w.x = pg8_pk4_fp8(o1 * 8.0f); w.y = pg8_pk4_fp8(o2 * 8.0f); if (mq == 0) wa = w; else wb = w;
                            ks[bj][0] += o1; ks[bj][1] += o2; }
                        { const auto s0 = __builtin_amdgcn_permlane16_swap(wa.x, wb.x, false, false); wa.x = s0[0]; wb.x = s0[1]; }
                        { const auto s1 = __builtin_amdgcn_permlane16_swap(wa.y, wb.y, false, false); wa.y = s1[0]; wb.y = s1[1]; }
                        const int row = row0 + ai * HALF + (m2 + (fq & 1)) * 16;
                        *(u32x4*)((unsigned char*)dst + (size_t)row * 2048 + colh + bj * HALF + cw - 8 * (fq & 1)) = (u32x4){wa.x, wa.y, wb.x, wb.y}; } }
            if (reg == 1) { PG8_EPI_WAIT();
#pragma unroll
                for (int bj = 0; bj < 2; ++bj)
#pragma unroll
                    for (int n = 0; n < 2; ++n)
#pragma unroll
                        for (int e = 0; e < 4; ++e) { float v = ks[bj][n][e];
                            v += __shfl_xor(v, 1); v += __shfl_xor(v, 2); v += __shfl_xor(v, 4); v += __shfl_xor(v, 8);
                            if (fr == 0) atomicAdd(kacc + ((size_t)((colh >> 7) + bj) * 64 + u.pm) * 128 + cw + 4 * n + e, v); }
            }
        } else if (reg <= 4) {
            bf16_t* dst = QKVUG + (size_t)reg * ((size_t)16384 * 2048); const int colh = colt - reg * 2048;
            PG8_RS_READY();
            if (reg == 2) {
#pragma unroll
              for (int ai = 0; ai < 2; ++ai)
#pragma unroll
                for (int m2 = 0; m2 < 4; m2 += 2)
#pragma unroll
                    for (int bj = 0; bj < 2; ++bj) { u32x2 wa, wb;
                        wa.x = pg8_pk4_fp8(acc[ai][bj][m2][0] * (rs[ai][m2] * 8.0f)); wa.y = pg8_pk4_fp8(acc[ai][bj][m2][1] * (rs[ai][m2] * 8.0f));
                        wb.x = pg8_pk4_fp8(acc[ai][bj][m2 + 1][0] * (rs[ai][m2 + 1] * 8.0f)); wb.y = pg8_pk4_fp8(acc[ai][bj][m2 + 1][1] * (rs[ai][m2 + 1] * 8.0f));
                        { const auto s0 = __builtin_amdgcn_permlane16_swap(wa.x, wb.x, false, false); wa.x = s0[0]; wb.x = s0[1]; }
                        { const auto s1 = __builtin_amdgcn_permlane16_swap(wa.y, wb.y, false, false); wa.y = s1[0]; wb.y = s1[1]; }
                        const int row = row0 + ai * HALF + (m2 + (fq & 1)) * 16;
                        *(u32x4*)((unsigned char*)dst + (size_t)row * 2048 + colh + bj * HALF + cw - 8 * (fq & 1)) = (u32x4){wa.x, wa.y, wb.x, wb.y}; }
            } else {
#pragma unroll
              for (int ai = 0; ai < 2; ++ai)
#pragma unroll
                for (int m = 0; m < 4; ++m) { const int row = row0 + ai * HALF + m * 16; const float r = rs[ai][m];
#pragma unroll
                    for (int bj = 0; bj < 2; ++bj) { f32x4 v0 = acc[ai][bj][m][0] * r, v1 = acc[ai][bj][m][1] * r;
#pragma unroll
                        for (int e = 0; e < 4; ++e) { v0[e] = gelu_tanh(v0[e]); v1[e] = gelu_tanh(v1[e]); }
                        u32x4 w; w.x = cvt_pk_bf16(v0[0], v0[1]); w.y = cvt_pk_bf16(v0[2], v0[3]); w.z = cvt_pk_bf16(v1[0], v1[1]); w.w = cvt_pk_bf16(v1[2], v1[3]);
                        *(u32x4*)(dst + (size_t)row * 2048 + colh + bj * HALF + cw) = w; } }
            }
        } else {
            const int gcol = colt - 10240 + cw;
            f32x4 bv[2][2];
#pragma unroll
            for (int bj = 0; bj < 2; ++bj) { bv[bj][0] = *(const f32x4*)(bgate + gcol + bj * HALF); bv[bj][1] = *(const f32x4*)(bgate + gcol + bj * HALF + 4); }
            PG8_RS_READY();
#pragma unroll
            for (int bj = 0; bj < 2; ++bj) { PG8_PIN(bv[bj][0]); PG8_PIN(bv[bj][1]); }
            const int odd = fq & 1;
#pragma unroll
            for (int ai = 0; ai < 2; ++ai)
#pragma unroll
                for (int m = 0; m < 4; m += 2)
#pragma unroll
                    for (int bj = 0; bj < 2; ++bj) { u32x2 wa, wb;
#pragma unroll
                        for (int mm = 0; mm < 2; ++mm) { const float r = rs[ai][m + mm]; f32x4 v0 = acc[ai][bj][m + mm][0] * r + bv[bj][0], v1 = acc[ai][bj][m + mm][1] * r + bv[bj][1];
#pragma unroll
                            for (int e = 0; e < 4; ++e) { v0[e] = sigm(v0[e]); v1[e] = sigm(v1[e]); }
                            u32x2 w; w.x = pg8_pk4_fp8((v0 - 0.5f) * 256.0f); w.y = pg8_pk4_fp8((v1 - 0.5f) * 256.0f); if (mm == 0) wa = w; else wb = w; }
                        { const auto s0 = __builtin_amdgcn_permlane16_swap(wa.x, wb.x, false, false); wa.x = s0[0]; wb.x = s0[1]; }
                        { const auto s1 = __builtin_amdgcn_permlane16_swap(wa.y, wb.y, false, false); wa.y = s1[0]; wb.y = s1[1]; }
                        const int row = row0 + ai * HALF + (m + odd) * 16;
                        *(u32x4*)((unsigned char*)G + (size_t)row * 8192 + gcol - 8 * odd + bj * HALF) = (u32x4){wa.x, wa.y, wb.x, wb.y}; }
        }
    }
};
template <int SECOND> struct EpiMix {
    static constexpr bool PERM = true, AFTER_DRAIN = false;
    const bf16_t* G; bf16_t* MIX; bf16_t* TMP; float descale; float smix;
    __device__ __forceinline__ void operator()(const f32x4 (&acc)[2][2][4][2], const Unit& u, int wr, int wc, int fr, int fq) const {
        asm volatile("" : "+v"(fr), "+v"(fq));
        const int row0 = u.pm * BM + wr * 64 + fr, col0 = u.pn * BM + wc * 32 + 8 * fq;
#pragma unroll
        for (int ai = 0; ai < 2; ++ai) {
            u32x2 wout[4][2];
            u32x2 gv[4][2], pv[4][2];
#pragma unroll
            for (int m = 0; m < 4; ++m)
#pragma unroll
                for (int bj = 0; bj < 2; ++bj) { const size_t row = (size_t)(row0 + ai * HALF + m * 16); const int col = col0 + bj * HALF;
                    gv[m][bj] = *(const u32x2*)((const unsigned char*)G + row * 8192 + SECOND * 4096 + col);
                    if (SECOND) pv[m][bj] = *(const u32x2*)((const unsigned char*)TMP + row * 4096 + col); }
            PG8_EPI_WAIT();
#pragma unroll
            for (int m = 0; m < 4; ++m)
#pragma unroll
                for (int bj = 0; bj < 2; ++bj) { PG8_PIN(gv[m][bj]); if (SECOND) PG8_PIN(pv[m][bj]); }
#pragma unroll
            for (int m = 0; m < 4; ++m)
#pragma unroll
                for (int bj = 0; bj < 2; ++bj) { const size_t row = (size_t)(row0 + ai * HALF + m * 16); const int col = col0 + bj * HALF;
                    const u32x2 g = gv[m][bj];
                    f32x4 v0 = acc[ai][bj][m][0] * descale, v1 = acc[ai][bj][m][1] * descale;
                    { const f32x2 g0 = __builtin_amdgcn_cvt_pk_f32_fp8((int)g.x, false), g1 = __builtin_amdgcn_cvt_pk_f32_fp8((int)g.x, true), g2 = __builtin_amdgcn_cvt_pk_f32_fp8((int)g.y, false), g3 = __builtin_amdgcn_cvt_pk_f32_fp8((int)g.y, true);
                      constexpr float GI = 1.0f / 256.0f;
                      v0[0] *= g0.x * GI + 0.5f; v0[1] *= g0.y * GI + 0.5f; v0[2] *= g1.x * GI + 0.5f; v0[3] *= g1.y * GI + 0.5f; v1[0] *= g2.x * GI + 0.5f; v1[1] *= g2.y * GI + 0.5f; v1[2] *= g3.x * GI + 0.5f; v1[3] *= g3.y * GI + 0.5f; }
#if defined(PROBE_NO_ATTN)
                    if (!SECOND) { v0 = v0 * 0.f; v1 = v1 * 0.f; }
#endif
                    if (SECOND) { const u32x2 p = pv[m][bj];
                        const f32x2 p0 = __builtin_amdgcn_cvt_pk_f32_fp8((int)p.x, false), p1 = __builtin_amdgcn_cvt_pk_f32_fp8((int)p.x, true), p2 = __builtin_amdgcn_cvt_pk_f32_fp8((int)p.y, false), p3 = __builtin_amdgcn_cvt_pk_f32_fp8((int)p.y, true);
                        v0[0] += p0.x * (1.0f / 64.0f); v0[1] += p0.y * (1.0f / 64.0f); v0[2] += p1.x * (1.0f / 64.0f); v0[3] += p1.y * (1.0f / 64.0f);
                        v1[0] += p2.x * (1.0f / 64.0f); v1[1] += p2.y * (1.0f / 64.0f); v1[2] += p3.x * (1.0f / 64.0f); v1[3] += p3.y * (1.0f / 64.0f); }
                    (void)row; (void)col;
                    if (SECOND) { wout[m][bj].x = pg8_pk4_fp8(v0 * smix); wout[m][bj].y = pg8_pk4_fp8(v1 * smix); }
                    else { wout[m][bj].x = pg8_pk4_fp8(v0 * 64.0f); wout[m][bj].y = pg8_pk4_fp8(v1 * 64.0f); } }
#pragma unroll
            for (int m = 0; m < 4; m += 2)
#pragma unroll
                for (int bj = 0; bj < 2; ++bj) { u32x2 wa = wout[m][bj], wb = wout[m + 1][bj];
                    { const auto s0 = __builtin_amdgcn_permlane16_swap(wa.x, wb.x, false, false); wa.x = s0[0]; wb.x = s0[1]; }
                    { const auto s1 = __builtin_amdgcn_permlane16_swap(wa.y, wb.y, false, false); wa.y = s1[0]; wb.y = s1[1]; }
                    const size_t row = (size_t)(row0 + ai * HALF + (m + (fq & 1)) * 16); const int col = col0 + bj * HALF - 8 * (fq & 1);
                    *(u32x4*)((unsigned char*)(SECOND ? MIX : TMP) + row * 4096 + col) = (u32x4){wa.x, wa.y, wb.x, wb.y}; }
        }
    }
};
struct EpiWo {
    static constexpr bool PERM = true, AFTER_DRAIN = false;
    const float* x; float* x1; bf16_t* x1b; float* ss2; float descale;
    __device__ __forceinline__ void operator()(const f32x4 (&acc)[2][2][4][2], const Unit& u, int wr, int wc, int fr, int fq) const {
        asm volatile("" : "+v"(fr), "+v"(fq));
        const int row0 = u.pm * BM + wr * 64 + fr, col0 = u.pn * BM + wc * 32 + 8 * fq;
        const unsigned short* xb = (const unsigned short*)x;
        u32x4 xr[2][4][2];
#pragma unroll
        for (int ai = 0; ai < 2; ++ai)
#pragma unroll
            for (int mm = 0; mm < 4; ++mm)
#pragma unroll
                for (int bj = 0; bj < 2; ++bj) xr[ai][mm][bj] = *(const u32x4*)(xb + (size_t)(row0 + ai * HALF + mm * 16) * 4096 + col0 + bj * HALF);
        PG8_EPI_WAIT();
#pragma unroll
        for (int ai = 0; ai < 2; ++ai)
#pragma unroll
            for (int mm = 0; mm < 4; ++mm)
#pragma unroll
                for (int bj = 0; bj < 2; ++bj) PG8_PIN(xr[ai][mm][bj]);
#pragma unroll
        for (int ai = 0; ai < 2; ++ai) {
#pragma unroll
                for (int mm = 0; mm < 4; ++mm) { const int m = mm; const int row = row0 + ai * HALF + m * 16; float sq = 0.f;
#pragma unroll
                    for (int bj = 0; bj < 2; ++bj) { const size_t o = (size_t)row * 4096 + col0 + bj * HALF; const u32x4 xw = xr[ai][mm][bj];
                        const f32x4 xa = {__uint_as_float(xw.x << 16), __uint_as_float(xw.x & 0xffff0000u), __uint_as_float(xw.y << 16), __uint_as_float(xw.y & 0xffff0000u)};
                        const f32x4 xc = {__uint_as_float(xw.z << 16), __uint_as_float(xw.z & 0xffff0000u), __uint_as_float(xw.w << 16), __uint_as_float(xw.w & 0xffff0000u)};
                        const f32x4 v0 = xa + acc[ai][bj][m][0] * descale, v1 = xc + acc[ai][bj][m][1] * descale;
                        u32x4 w; w.x = cvt_pk_bf16(v0[0], v0[1]); w.y = cvt_pk_bf16(v0[2], v0[3]); w.z = cvt_pk_bf16(v1[0], v1[1]); w.w = cvt_pk_bf16(v1[2], v1[3]);
                        *(u32x4*)(x1b + o) = w;
                        sq += (v0[0] * v0[0] + v0[1] * v0[1]) + (v0[2] * v0[2] + v0[3] * v0[3]) + (v1[0] * v1[0] + v1[1] * v1[1]) + (v1[2] * v1[2] + v1[3] * v1[3]); }
                    sq += __shfl_xor(sq, 16); sq += __shfl_xor(sq, 32);
                    if (fq == 0) ss2[(size_t)row * 64 + u.pn * 4 + wc] = sq; }
            }
    }
};
struct EpiNull {
    static constexpr bool PERM = true, AFTER_DRAIN = false;
    __device__ __forceinline__ void operator()(const f32x4 (&acc)[2][2][4][2], const Unit& u, int wr, int wc, int fr, int fq) const {
#pragma unroll
        for (int ai = 0; ai < 2; ++ai)
#pragma unroll
            for (int bj = 0; bj < 2; ++bj)
#pragma unroll
                for (int m = 0; m < 4; ++m) { asm volatile("" :: "v"(acc[ai][bj][m][0]), "v"(acc[ai][bj][m][1])); } }
};
struct EpiS {
    static constexpr bool PERM = true, AFTER_DRAIN = false;
    float* S;
    __device__ __forceinline__ void operator()(const f32x4 (&acc)[2][2][4][2], const Unit& u, int wr, int wc, int fr, int fq) const {
        asm volatile("" : "+v"(fr), "+v"(fq));
        const int row0 = u.pm * BM + wr * 64 + fr, col0 = u.pn * BM + wc * 32 + 8 * fq;
#pragma unroll
        for (int ai = 0; ai < 2; ++ai)
#pragma unroll
            for (int m = 0; m < 4; ++m) { const int row = row0 + ai * HALF + m * 16;
#pragma unroll
                for (int bj = 0; bj < 2; ++bj) {
                    typedef _Float16 h2_t __attribute__((ext_vector_type(2)));
                    const f32x4 a0 = acc[ai][bj][m][0], a1 = acc[ai][bj][m][1];
                    u32x4 w; w.x = __builtin_bit_cast(unsigned, __builtin_amdgcn_cvt_pkrtz(a0[0], a0[1])); w.y = __builtin_bit_cast(unsigned, __builtin_amdgcn_cvt_pkrtz(a0[2], a0[3]));
                    w.z = __builtin_bit_cast(unsigned, __builtin_amdgcn_cvt_pkrtz(a1[0], a1[1])); w.w = __builtin_bit_cast(unsigned, __builtin_amdgcn_cvt_pkrtz(a1[2], a1[3]));
                    *(u32x4*)((unsigned short*)S + (size_t)row * 2048 + col0 + bj * HALF) = w; } }
    }
};
typedef int i32x8 __attribute__((ext_vector_type(8)));
typedef int i32x4 __attribute__((ext_vector_type(4)));
__device__ __forceinline__ i32x8 pg8_cat(bf16x8 lo, bf16x8 hi) { const i32x4 a = __builtin_bit_cast(i32x4, lo), b = __builtin_bit_cast(i32x4, hi); return __builtin_shufflevector(a, b, 0, 1, 2, 3, 4, 5, 6, 7); }
template <class Epi, class Sched, bool ALIGN_EPI = false, bool SP2 = false, bool F8 = false>
__device__ __forceinline__ void gemm_phase(PG8_LAS unsigned char* lds, const Gemm g, const Sched& S, const Epi& E) {
    const int tid = threadIdx.x, wid = __builtin_amdgcn_readfirstlane(tid >> 6), lane = tid & 63, wr = wid >> 2, wc = wid & 3, fr = lane & 15, fq = lane >> 4;
    constexpr int ESZ = F8 ? 1 : 2;
    const int K = g.K, nt = (K * ESZ) / 128;
    unsigned voffA[2], voffB[2];
#pragma unroll
    for (int i = 0; i < 2; ++i) { int R, C; stage_rc(tid * 16 + i * 8192, R, C); const int Rb = Epi::PERM ? ((R & ~31) + perm32(R & 31)) : R;
        voffA[i] = (unsigned)(R * K * ESZ + C * 2); voffB[i] = (unsigned)(Rb * K * ESZ + C * 2); }
    const size_t kstep = (size_t)(BK * 2);
    const size_t hstep = (size_t)HALF * K * ESZ;
    const size_t tstep = 2 * hstep;
    const unsigned ldsw = (unsigned)wid * 1024u;
    const int aoff0 = lds_byte(wr * 64 + fr, fq * 8), aoff1 = aoff0 + 1024;
    const int boff0 = lds_byte(wc * 32 + fr, fq * 8), boff1 = boff0 + 1024;
#define PG8_SA(b, h) (((b) * 2 + (h)) * HTB)
#define PG8_SB(b, h) ((4 + (b) * 2 + (h)) * HTB)
#define PG8_STAGE(bufoff, gbase, voff) do { _Pragma("unroll") for (int _i = 0; _i < 2; ++_i) \
        __builtin_amdgcn_global_load_lds((const unsigned*)((const char*)(gbase) + (voff)[_i]), (PG8_LAS unsigned*)(lds + (bufoff) + ldsw + _i * 8192), 16, 0, 0); } while (0)
#define PG8_LDA(dst, b, h) do { if constexpr (F8) { _Pragma("unroll") for (int m = 0; m < 4; ++m) dst##8[m] = pg8_cat(*(const PG8_LAS bf16x8*)(lds + PG8_SA(b, h) + aoff0 + m * 2048), *(const PG8_LAS bf16x8*)(lds + PG8_SA(b, h) + aoff1 + m * 2048)); }     \
    else { _Pragma("unroll") for (int m = 0; m < 4; ++m) _Pragma("unroll") for (int k = 0; k < 2; ++k) dst[m][k] = *(const PG8_LAS bf16x8*)(lds + PG8_SA(b, h) + (k ? aoff1 : aoff0) + m * 2048); } } while (0)
#define PG8_LDB(dst, b, h) do { if constexpr (F8) { _Pragma("unroll") for (int n = 0; n < 2; ++n) dst##8[n] = pg8_cat(*(const PG8_LAS bf16x8*)(lds + PG8_SB(b, h) + boff0 + n * 2048), *(const PG8_LAS bf16x8*)(lds + PG8_SB(b, h) + boff1 + n * 2048)); } \
    else { _Pragma("unroll") for (int n = 0; n < 2; ++n) _Pragma("unroll") for (int k = 0; k < 2; ++k) dst[n][k] = *(const PG8_LAS bf16x8*)(lds + PG8_SB(b, h) + (k ? boff1 : boff0) + n * 2048); } } while (0)
#define PG8_MMA(ai, bj, At, Bt) do { __builtin_amdgcn_s_setprio(1); _Pragma("unroll") for (int m = 0; m < 4; ++m) _Pragma("unroll") for (int n = 0; n < 2; ++n) { \
        if constexpr (F8) asm volatile("v_mfma_scale_f32_16x16x128_f8f6f4 %0, %1, %2, %0, %3, %3 op_sel_hi:[0,0,0]" : "+v"(acc[ai][bj][m][n]) : "v"(Bt##8[n]), "v"(At##8[m]), "v"(mxs));   \
        else { _Pragma("unroll") for (int k = 0; k < 2; ++k) acc[ai][bj][m][n] = __builtin_amdgcn_mfma_f32_16x16x32_bf16(Bt[n][k], At[m][k], acc[ai][bj][m][n], 0, 0, 0); } } __builtin_amdgcn_s_setprio(0); } while (0)
#define PG8_WAIT_V(n) asm volatile("s_waitcnt vmcnt(" #n ")" ::: "memory")
#define PG8_WAIT_L(n) asm volatile("s_waitcnt lgkmcnt(" #n ")" ::: "memory")
#define PG8_BAR __builtin_amdgcn_s_barrier()
#define PG8_SCHED __builtin_amdgcn_sched_barrier(0)
    Unit cur, nxt; int ui = 0;
    if (!S.next(0, cur)) return;
    f32x4 acc[2][2][4][2];
#pragma unroll
    for (int a = 0; a < 2; ++a)
#pragma unroll
        for (int b = 0; b < 2; ++b)
#pragma unroll
            for (int m = 0; m < 4; ++m)
#pragma unroll
                for (int n = 0; n < 2; ++n) acc[a][b][m][n] = (f32x4){0.f, 0.f, 0.f, 0.f};
    int mxs = 0x7f7f7f7f; asm volatile("" : "+v"(mxs));
    bf16x8 At[4][2], B0[2][2], B1[2][2];
    i32x8 At8[4], B08[2], B18[2];
    const char* cA = (const char*)g.A + (size_t)cur.pm * tstep; const char* cB = (const char*)g.Bt + (size_t)cur.pn * tstep;
    S.a_ready(cur);
    if constexpr (SP2) {
        PG8_STAGE(PG8_SB(0, 0), cB, voffB); PG8_STAGE(PG8_SB(0, 1), cB + hstep, voffB); PG8_STAGE(PG8_SA(0, 0), cA, voffA); PG8_STAGE(PG8_SA(0, 1), cA + hstep, voffA);
        if (wr == 1) PG8_BAR;
        PG8_WAIT_V(2); PG8_BAR;
        PG8_STAGE(PG8_SB(1, 0), cB + kstep, voffB); PG8_STAGE(PG8_SA(1, 0), cA + kstep, voffA); PG8_STAGE(PG8_SB(1, 1), cB + hstep + kstep, voffB);
        PG8_WAIT_V(6); PG8_BAR;
    } else {
        PG8_STAGE(PG8_SB(0, 0), cB, voffB); PG8_STAGE(PG8_SA(0, 0), cA, voffA); PG8_STAGE(PG8_SB(0, 1), cB + hstep, voffB); PG8_STAGE(PG8_SA(0, 1), cA + hstep, voffA);
        if (wr == 1) PG8_BAR;
        PG8_WAIT_V(4); PG8_BAR;
        PG8_STAGE(PG8_SB(1, 0), cB + kstep, voffB); PG8_STAGE(PG8_SA(1, 0), cA + kstep, voffA); PG8_STAGE(PG8_SB(1, 1), cB + hstep + kstep, voffB);
        PG8_WAIT_V(6); PG8_BAR;
    }
    for (;;) {
        const bool has_next = S.next(ui + 1, nxt);
        const char* nA = has_next ? (const char*)g.A + (size_t)nxt.pm * tstep : cA; const char* nB = has_next ? (const char*)g.Bt + (size_t)nxt.pn * tstep : cB;
        for (int t = 0; t < nt; t += 2) {
            const bool last = (t == nt - 2);
            const char* a1 = cA + (size_t)(t + 1) * kstep;
            const char* a2 = last ? nA : cA + (size_t)(t + 2) * kstep; const char* b2 = last ? nB : cB + (size_t)(t + 2) * kstep;
            const char* a3 = a2 + kstep; const char* b3 = b2 + kstep;
            if (last && has_next) S.a_ready(nxt);
            if constexpr (SP2) {
            PG8_LDB(B0, 0, 0); PG8_LDB(B1, 0, 1); PG8_SCHED; PG8_LDA(At, 0, 0); PG8_STAGE(PG8_SA(1, 1), a1 + hstep, voffA);
            PG8_WAIT_V(8); PG8_WAIT_L(0); PG8_BAR; PG8_MMA(0, 0, At, B0); PG8_MMA(0, 1, At, B1); PG8_BAR; PG8_SCHED;
            PG8_LDA(At, 0, 1); PG8_STAGE(PG8_SB(0, 0), b2, voffB); PG8_STAGE(PG8_SB(0, 1), b2 + hstep, voffB); PG8_STAGE(PG8_SA(0, 0), a2, voffA);
            PG8_WAIT_V(8); PG8_WAIT_L(0); PG8_BAR; PG8_MMA(1, 0, At, B0); PG8_MMA(1, 1, At, B1); PG8_BAR; PG8_SCHED;
            PG8_LDB(B0, 1, 0); PG8_LDB(B1, 1, 1); PG8_SCHED; PG8_LDA(At, 1, 0); PG8_STAGE(PG8_SA(0, 1), a2 + hstep, voffA);
            PG8_WAIT_V(8); PG8_WAIT_L(0); PG8_BAR; PG8_MMA(0, 0, At, B0); PG8_MMA(0, 1, At, B1); PG8_BAR; PG8_SCHED;
            PG8_LDA(At, 1, 1); PG8_STAGE(PG8_SB(1, 0), b3, voffB); PG8_STAGE(PG8_SB(1, 1), b3 + hstep, voffB); PG8_STAGE(PG8_SA(1, 0), a3, voffA);
            PG8_WAIT_V(8); PG8_WAIT_L(0); PG8_BAR; PG8_MMA(1, 0, At, B0); PG8_MMA(1, 1, At, B1); PG8_BAR; PG8_SCHED;
            } else {
            PG8_LDB(B0, 0, 0); PG8_SCHED; PG8_LDA(At, 0, 0); PG8_STAGE(PG8_SA(1, 1), a1 + hstep, voffA);
            PG8_WAIT_L(8); PG8_BAR; PG8_WAIT_L(0); PG8_MMA(0, 0, At, B0); PG8_BAR; PG8_SCHED;
            PG8_LDB(B1, 0, 1); PG8_STAGE(PG8_SB(0, 0), b2, voffB);
            PG8_BAR; PG8_WAIT_L(0); PG8_MMA(0, 1, At, B1); PG8_BAR;
            PG8_LDA(At, 0, 1); PG8_STAGE(PG8_SA(0, 0), a2, voffA);
            PG8_BAR; PG8_WAIT_L(0); PG8_MMA(1, 0, At, B0); PG8_BAR; PG8_SCHED;
            PG8_STAGE(PG8_SB(0, 1), b2 + hstep, voffB);
            PG8_WAIT_V(6); PG8_BAR; PG8_MMA(1, 1, At, B1); PG8_BAR;
            PG8_LDB(B0, 1, 0); PG8_SCHED; PG8_LDA(At, 1, 0); PG8_STAGE(PG8_SA(0, 1), a2 + hstep, voffA);
            PG8_WAIT_L(8); PG8_BAR; PG8_WAIT_L(0); PG8_MMA(0, 0, At, B0); PG8_BAR; PG8_SCHED;
            PG8_LDB(B1, 1, 1); PG8_STAGE(PG8_SB(1, 0), b3, voffB);
            PG8_BAR; PG8_WAIT_L(0); PG8_MMA(0, 1, At, B1); PG8_BAR;
            PG8_LDA(At, 1, 1); PG8_STAGE(PG8_SA(1, 0), a3, voffA);
            PG8_BAR; PG8_WAIT_L(0); PG8_MMA(1, 0, At, B0); PG8_BAR; PG8_SCHED;
            PG8_STAGE(PG8_SB(1, 1), b3 + hstep, voffB);
            PG8_WAIT_V(6); PG8_BAR; PG8_MMA(1, 1, At, B1); PG8_BAR;
            }
        }
        if constexpr (ALIGN_EPI) { if (wr == 0) PG8_BAR; }
        if constexpr (!Epi::AFTER_DRAIN) { E(acc, cur, wr, wc, fr, fq); S.done(cur);
#if defined(PROBE_EPI_DRAIN)
            PG8_WAIT_V(0);
#endif
        }
        if (!has_next) break;
#pragma unroll
        for (int a = 0; a < 2; ++a)
#pragma unroll
            for (int b = 0; b < 2; ++b)
#pragma unroll
                for (int m = 0; m < 4; ++m)
#pragma unroll
                    for (int n = 0; n < 2; ++n) acc[a][b][m][n] = (f32x4){0.f, 0.f, 0.f, 0.f};
        cur = nxt; cA = nA; cB = nB; ++ui;
        if constexpr (ALIGN_EPI) { if (wr == 1) PG8_BAR; }
    }
    PG8_WAIT_V(0);
    if constexpr (!ALIGN_EPI) { if (wr == 0) PG8_BAR; }
    PG8_BAR;
    if constexpr (Epi::AFTER_DRAIN) { E.fused(acc, cur, wr, wc, fr, fq, lds, wid, lane); S.done(cur); }
#undef PG8_SA
#undef PG8_SB
#undef PG8_STAGE
#undef PG8_LDA
#undef PG8_LDB
#undef PG8_MMA
#undef PG8_WAIT_V
#undef PG8_WAIT_L
#undef PG8_BAR
#undef PG8_SCHED
}
}
#define LAS __attribute__((address_space(3)))
#define XB_TMO      128
#define XB_XCNT(j)  (256  + 64 * (j))
#define XB_XSUB(j)  (1280 + 64 * (j))
#define XB_XGEN(j)  (2304 + 64 * (j))
#define XB_TOP      3328
#define XB_TOPGEN   3392
#define XCD_BAR_WORDS 3456
#define XB_SPIN_CAP (1u << 24)

__device__ __forceinline__ unsigned xb_ld(unsigned* p)              { return __hip_atomic_load(p, __ATOMIC_RELAXED, __HIP_MEMORY_SCOPE_AGENT); }
__device__ __forceinline__ unsigned xb_add(unsigned* p, unsigned v) { return __hip_atomic_fetch_add(p, v, __ATOMIC_RELAXED, __HIP_MEMORY_SCOPE_AGENT); }
__device__ __forceinline__ unsigned xb_xcc_id() { return (unsigned)__builtin_amdgcn_s_getreg((3 << 11) | 20) & 0xFu; }
#define XB_SPIN(cond, bar) do { unsigned _sp = 0; while (cond) { __builtin_amdgcn_s_sleep(1); \
    if ((++_sp & 255u) == 0u) { if (xb_ld(&(bar)[XB_TMO])) break; if (_sp > XB_SPIN_CAP) { atomicAdd(&(bar)[XB_TMO], 1u); break; } } } } while (0)

struct XcdBarrier {
    unsigned* bar; unsigned x;
    volatile LAS unsigned* st;
};

__device__ __forceinline__ XcdBarrier xcd_barrier_post(unsigned* bar, volatile LAS unsigned* st) {
    XcdBarrier b; b.bar = bar; b.x = xb_xcc_id(); b.st = st;
    if (threadIdx.x == 0) (void)xb_add(&bar[XB_XCNT(b.x)], 1u);
    return b;
}
__device__ __forceinline__ void xcd_barrier_complete(unsigned* bar, unsigned x, unsigned& nloc, unsigned& nx) {
    const unsigned G = gridDim.x * gridDim.y * gridDim.z;
    unsigned sum, cnt, mine, sp = 0u;
    for (;;) {
        sum = 0u; cnt = 0u; mine = 0u;
#pragma unroll
        for (unsigned j = 0; j < 16; ++j) { const unsigned c = xb_ld(&bar[XB_XCNT(j)]); sum += c; cnt += (c > 0u) ? 1u : 0u; mine = (j == x) ? c : mine; }
        if (sum == G) break;
        __builtin_amdgcn_s_sleep(1);
        if ((++sp & 255u) == 0u) { if (xb_ld(&bar[XB_TMO])) break; if (sp > XB_SPIN_CAP) { atomicAdd(&bar[XB_TMO], 1u); break; } }
    }
    nloc = mine > 0u ? mine : 1u; nx = cnt > 0u ? cnt : 1u;
}

__device__ __forceinline__ void xcd_barrier(const XcdBarrier& b) {
    asm volatile("s_waitcnt vmcnt(0)" ::: "memory");
    __syncthreads();
    if (threadIdx.x == 0) {
        unsigned* bar = b.bar;
        __builtin_amdgcn_s_waitcnt(0);
        unsigned nloc = b.st[0], nx = b.st[1];
        if (nloc == 0u) { xcd_barrier_complete(bar, b.x, nloc, nx); b.st[0] = nloc; b.st[1] = nx; }
        const unsigned old = xb_add(&bar[XB_XSUB(b.x)], 1u);
        const unsigned gen = old / nloc;
        if (old + 1u == (gen + 1u) * nloc) {
            __builtin_amdgcn_fence(__ATOMIC_RELEASE, "agent");
            asm volatile("s_waitcnt vmcnt(0)" ::: "memory");
            const unsigned og = xb_add(&bar[XB_TOP], 1u);
            const unsigned tg = og / nx;
            if (og + 1u == (tg + 1u) * nx) xb_add(&bar[XB_TOPGEN], 1u);
            else XB_SPIN(xb_ld(&bar[XB_TOPGEN]) == tg, bar);
            __builtin_amdgcn_fence(__ATOMIC_ACQUIRE, "agent");
            xb_add(&bar[XB_XGEN(b.x)], 1u);
            asm volatile("s_waitcnt vmcnt(0)" ::: "memory");
        } else {
            XB_SPIN(xb_ld(&bar[XB_XGEN(b.x)]) == gen, bar);
            __builtin_amdgcn_fence(__ATOMIC_ACQUIRE, "agent");
            asm volatile("s_waitcnt vmcnt(0)" ::: "memory");
        }
    }
    __syncthreads();
}
#ifndef PROBE_DUP
#define PROBE_DUP -1
#endif
#ifndef PROBE_PMODE
#define PROBE_PMODE 0
#endif

constexpr int T = 16384, D = 4096, AW = 2048, NH = 16, HD = 128, NBLK = 64, BLK = 256, N1 = 18432, GWD = 8192;
constexpr int NWAVES = 8;
constexpr float EPS = 1e-6f;
#ifndef N_LAUNCH
#define N_LAUNCH 1
#endif
constexpr int NPHASE = 9;

constexpr size_t MiB = 1u << 20;
constexpr size_t WS_CTL = 0, CTL_ZERO_BYTES = 1 * MiB;
constexpr int CW_BAR = 4096;
constexpr size_t CB_CNT = 160 * 1024;
constexpr size_t CB_KACC = 256 * 1024;
static_assert((CW_BAR + 9 * 3456) * 4 <= (int)CB_CNT && CB_KACC + 512 * 1024 <= CTL_ZERO_BYTES, "ctl map");
constexpr size_t WS_SS1 = 1 * MiB;
constexpr size_t WS_SS2 = 1108 * MiB;
constexpr size_t WS_COS = 2 * MiB, WS_SIN = 6 * MiB;
constexpr size_t WS_LIST = 10 * MiB;
constexpr size_t WS_ML = 44 * MiB;
constexpr size_t WS_WAP = 52 * MiB, WS_WSP = 68 * MiB, WS_WO = 84 * MiB, WS_W2 = 116 * MiB;
constexpr size_t WS_XB = 132 * MiB, WS_XB8 = 260 * MiB;
#ifndef ZUZV_FP8
#define ZUZV_FP8 1
#endif
constexpr size_t WS_W1Z = 980 * MiB, WS_W18 = 1012 * MiB;
constexpr size_t WS_AO8 = 980 * MiB;
constexpr size_t WS_OP = 132 * MiB;
constexpr size_t WS_Q = 404 * MiB, WS_K = 468 * MiB, WS_V = 532 * MiB, WS_U = 596 * MiB, WS_GV = 660 * MiB;
constexpr size_t WS_G = 724 * MiB;
constexpr size_t WS_AO = 980 * MiB, WS_SO = 1044 * MiB;
constexpr size_t WS_MIX = 132 * MiB, WS_X1B = 260 * MiB;
constexpr size_t WS_TU = 404 * MiB, WS_TV = 468 * MiB;
constexpr size_t WS_S = 724 * MiB;
constexpr size_t WS_XBF = 852 * MiB;
constexpr size_t WS_END = 1112 * MiB;
constexpr size_t LIST_HEAD_STRIDE = 516096;

constexpr int RING_BYTES = 131072;
constexpr int LDS_PRE = RING_BYTES;
constexpr int PEER_WAVE_LDS = 19456;
constexpr int LDS_MISC = 8 * PEER_WAVE_LDS;
constexpr int LDS_BYTES = LDS_MISC + 256;

#define GAS __attribute__((address_space(1)))
typedef unsigned short bf16;
typedef unsigned v4u __attribute__((ext_vector_type(4)));
typedef unsigned v2u __attribute__((ext_vector_type(2)));
typedef float f32x4 __attribute__((ext_vector_type(4)));
typedef float f32x2 __attribute__((ext_vector_type(2)));
typedef float f32x16 __attribute__((ext_vector_type(16)));
typedef short bf16x8 __attribute__((ext_vector_type(8)));
typedef short s16x4 __attribute__((ext_vector_type(4)));
#define LDS_WAIT() asm volatile("s_waitcnt lgkmcnt(0)" ::: "memory")
#define VM_WAIT() asm volatile("s_waitcnt vmcnt(0)" ::: "memory")
#define PIN(v) asm volatile("s_waitcnt vmcnt(0)" : "+v"(v) : : "memory")
typedef __bf16 bf16x2_t __attribute__((ext_vector_type(2)));
__device__ __forceinline__ unsigned cvtpk(float lo, float hi) { const f32x2 v = {lo, hi}; const bf16x2_t r = __builtin_convertvector(v, bf16x2_t); return __builtin_bit_cast(unsigned, r); }
constexpr float S_QKV = 8.0f;
__device__ __forceinline__ bf16x8 pack8(f32x4 a, f32x4 b);
__device__ __forceinline__ bf16x8 fp8x8_to_bf16(v2u w) {
    const f32x2 p0 = __builtin_amdgcn_cvt_pk_f32_fp8((int)w.x, false), p1 = __builtin_amdgcn_cvt_pk_f32_fp8((int)w.x, true), p2 = __builtin_amdgcn_cvt_pk_f32_fp8((int)w.y, false), p3 = __builtin_amdgcn_cvt_pk_f32_fp8((int)w.y, true);
    return pack8((f32x4){p0.x, p0.y, p1.x, p1.y}, (f32x4){p2.x, p2.y, p3.x, p3.y}); }
__device__ __forceinline__ bf16x8 pack8(f32x4 a, f32x4 b) { v4u w; w.x = cvtpk(a[0], a[1]); w.y = cvtpk(a[2], a[3]); w.z = cvtpk(b[0], b[1]); w.w = cvtpk(b[2], b[3]); return __builtin_bit_cast(bf16x8, w); }
__device__ __forceinline__ float clamp448(float x) { return fminf(fmaxf(x, -448.0f), 448.0f); }
__device__ __forceinline__ unsigned pk4_fp8(f32x4 a) { int w = 0; w = __builtin_amdgcn_cvt_pk_fp8_f32(clamp448(a[0]), clamp448(a[1]), w, false); w = __builtin_amdgcn_cvt_pk_fp8_f32(clamp448(a[2]), clamp448(a[3]), w, true); return (unsigned)w; }
#ifndef SGU_FP8
#define SGU_FP8 1
#endif
constexpr float S_SO = 16.0f, S_WSP = 128.0f;
constexpr float S_OP = 32.0f;
constexpr float S_X = 16.0f, S_W1 = 256.0f, S_AO = 64.0f, S_WAP = 128.0f, S_MIX = 16.0f, S_WO = 256.0f;
__device__ __forceinline__ float bflo(unsigned w) { return __uint_as_float(w << 16); }
__device__ __forceinline__ float bfhi(unsigned w) { return __uint_as_float(w & 0xffff0000u); }
__device__ __forceinline__ float wave_sum(float v) {
#pragma unroll
    for (int o = 1; o < 64; o <<= 1) v += __shfl_xor(v, o);
    return v;
}
#define DPP_I(v, ctrl) __builtin_amdgcn_update_dpp(0, (v), (ctrl), 0xF, 0xF, true)
__device__ __forceinline__ int imax(int a, int b) { return a > b ? a : b; }
__device__ __forceinline__ int row16_max_i(int v) { v = imax(v, DPP_I(v, 0xB1)); v = imax(v, DPP_I(v, 0x4E)); v = imax(v, DPP_I(v, 0x141)); v = imax(v, DPP_I(v, 0x140)); return v; }
__device__ __forceinline__ int half32_max_i(int v) { v = row16_max_i(v); const auto r = __builtin_amdgcn_permlane16_swap((unsigned)v, (unsigned)v, false, false); return imax((int)r[0], (int)r[1]); }
__device__ __forceinline__ int wave_max_fast_i(int v) { v = half32_max_i(v); const auto q = __builtin_amdgcn_permlane32_swap((unsigned)v, (unsigned)v, false, false); return imax((int)q[0], (int)q[1]); }
__device__ __forceinline__ float wave_sum_fast(float x) {
    int v = __float_as_int(x);
    x += __int_as_float(DPP_I(v, 0xB1)); v = __float_as_int(x); x += __int_as_float(DPP_I(v, 0x4E)); v = __float_as_int(x);
    x += __int_as_float(DPP_I(v, 0x141)); v = __float_as_int(x); x += __int_as_float(DPP_I(v, 0x140)); v = __float_as_int(x);
    const auto r = __builtin_amdgcn_permlane16_swap((unsigned)v, (unsigned)v, false, false); x = __uint_as_float(r[0]) + __uint_as_float(r[1]); v = __float_as_int(x);
    const auto q = __builtin_amdgcn_permlane32_swap((unsigned)v, (unsigned)v, false, false); return __uint_as_float(q[0]) + __uint_as_float(q[1]);
}
__device__ __forceinline__ int wave_max_i(int v) {
#pragma unroll
    for (int o = 1; o < 64; o <<= 1) { const int t = __shfl_xor(v, o); v = t > v ? t : v; }
    return v;
}
__device__ __forceinline__ unsigned offb(unsigned row, unsigned ch) { return 256u * row + 16u * (ch ^ (((row & 3u) << 2) | ((row >> 2) & 3u))); }
__device__ __forceinline__ bf16x8 tr_read2(unsigned a_lo, unsigned a_hi) {
    s16x4 lo, hi; asm volatile("ds_read_b64_tr_b16 %0, %2\n\tds_read_b64_tr_b16 %1, %3\n\ts_waitcnt lgkmcnt(0)" : "=&v"(lo), "=&v"(hi) : "v"(a_lo), "v"(a_hi) : "memory");
    return (bf16x8){lo[0], lo[1], lo[2], lo[3], hi[0], hi[1], hi[2], hi[3]}; }
__device__ __forceinline__ void tr_read4(unsigned a0, unsigned a1, unsigned a2, unsigned a3, bf16x8& o0, bf16x8& o1) {
    s16x4 r0, r1, r2, r3;
    asm volatile("ds_read_b64_tr_b16 %0, %4\n\tds_read_b64_tr_b16 %1, %5\n\tds_read_b64_tr_b16 %2, %6\n\tds_read_b64_tr_b16 %3, %7\n\ts_waitcnt lgkmcnt(0)"
                 : "=&v"(r0), "=&v"(r1), "=&v"(r2), "=&v"(r3) : "v"(a0), "v"(a1), "v"(a2), "v"(a3) : "memory");
    o0 = (bf16x8){r0[0], r0[1], r0[2], r0[3], r1[0], r1[1], r1[2], r1[3]}; o1 = (bf16x8){r2[0], r2[1], r2[2], r2[3], r3[0], r3[1], r3[2], r3[3]};
}
#define MFMA32(a, b, c) __builtin_amdgcn_mfma_f32_32x32x16_bf16((a), (b), (c), 0, 0, 0)

struct Params {
    const float *x, *norm_mix_g, *w_in, *w_attn_proj, *sgu_norm_g, *sgu_w, *sgu_b, *w_sgu_proj, *w_gate, *b_gate, *w_o, *norm_ffn_g, *peer_wq, *peer_subkeys, *peer_u, *peer_v, *norm_final_g;
    float* out; unsigned char* ws; int ph_lo, ph_hi, li, pad;
};

__device__ __forceinline__ void p0_transpose_item(const float* W, int K, int N, bf16* WT, int row_off, int permqk, const float* gk, LAS float* scr, int item, int lane) {
    const int nblk = N / 32, kb = item / nblk, nb = item % nblk, k0 = 64 * kb, n0 = 32 * nb;
    float wv_[32];
#pragma unroll
    for (int i = 0; i < 32; ++i) wv_[i] = W[(size_t)(k0 + 2 * i + (lane >> 5)) * N + n0 + (lane & 31)];
#pragma unroll
    for (int i = 0; i < 32; ++i) { const int kk = 2 * i + (lane >> 5); const float g = gk ? gk[k0 + kk] : 1.0f; scr[kk * 33 + (lane & 31)] = wv_[i] * g; }
    LDS_WAIT(); asm volatile("" ::: "memory");
    const int c = lane & 7;
    VM_WAIT();
#pragma unroll
    for (int j = 0; j < 4; ++j) { const int n = (lane >> 3) + 8 * j; const LAS float* s = scr + (8 * c) * 33 + n;
        v4u o; o.x = cvtpk(s[0 * 33], s[1 * 33]); o.y = cvtpk(s[2 * 33], s[3 * 33]); o.z = cvtpk(s[4 * 33], s[5 * 33]); o.w = cvtpk(s[6 * 33], s[7 * 33]);
        int nn = n0 + n;
        if (permqk && nn < 4096) { const int d = nn & 127, i = d & 63, hf = d >> 6; nn = (nn & ~127) + 8 * (i >> 2) + 4 * hf + (i & 3); }
        *(v4u*)(WT + (size_t)(row_off + nn) * K + k0 + 8 * c) = o; }
    LDS_WAIT(); asm volatile("" ::: "memory");
}
__device__ __forceinline__ void p0_transpose_item8(const float* W, int K, int N, unsigned char* WT, int row_off, int permqk, const float* gk, float scale, LAS float* scr, int item, int lane) {
    const int nblk = N / 32, kb = item / nblk, nb = item % nblk, k0 = 64 * kb, n0 = 32 * nb;
    float wv_[32];
#pragma unroll
    for (int i = 0; i < 32; ++i) wv_[i] = W[(size_t)(k0 + 2 * i + (lane >> 5)) * N + n0 + (lane & 31)];
#pragma unroll
    for (int i = 0; i < 32; ++i) { const int kk = 2 * i + (lane >> 5); const float g = gk ? gk[k0 + kk] : 1.0f; scr[kk * 33 + (lane & 31)] = wv_[i] * (g * scale); }
    LDS_WAIT(); asm volatile("" ::: "memory");
    const int c = lane & 3;
    VM_WAIT();
#pragma unroll
    for (int j = 0; j < 2; ++j) { const int n = (lane >> 2) + 16 * j; const LAS float* s = scr + (16 * c) * 33 + n;
        v4u o;
        o.x = pk4_fp8((f32x4){s[0 * 33], s[1 * 33], s[2 * 33], s[3 * 33]}); o.y = pk4_fp8((f32x4){s[4 * 33], s[5 * 33], s[6 * 33], s[7 * 33]});
        o.z = pk4_fp8((f32x4){s[8 * 33], s[9 * 33], s[10 * 33], s[11 * 33]}); o.w = pk4_fp8((f32x4){s[12 * 33], s[13 * 33], s[14 * 33], s[15 * 33]});
        int nn = n0 + n;
        if (permqk && nn < 4096) { const int d = nn & 127, i = d & 63, hf = d >> 6; nn = (nn & ~127) + 8 * (i >> 2) + 4 * hf + (i & 3); }
        *(v4u*)(WT + (size_t)(row_off + nn) * K + k0 + 16 * c) = o; }
    LDS_WAIT(); asm volatile("" ::: "memory");
}
__device__ __forceinline__ void p0_prologue(const Params& p, LAS unsigned char* lds, int tid, int lane, int wave) {
    unsigned char* ws = p.ws;
    const int gw = blockIdx.x * NWAVES + wave, NGW = gridDim.x * NWAVES;
    { bf16* XB = (bf16*)(ws + WS_XB); float* ss1 = (float*)(ws + WS_SS1);
      for (int row = gw; row < T; row += NGW) { const f32x4* xr = (const f32x4*)(p.x + (size_t)row * D); float s = 0.f;
          f32x4 xa[8], xb2[8];
#pragma unroll
          for (int j = 0; j < 8; ++j) { xa[j] = xr[128 * j + 2 * lane]; xb2[j] = xr[128 * j + 2 * lane + 1]; }
          VM_WAIT();
#pragma unroll
          for (int j = 0; j < 8; ++j) { PIN(xa[j]); PIN(xb2[j]); }
#pragma unroll
          for (int j = 0; j < 8; ++j) { const f32x4 a = xa[j], b = xb2[j];
              s += (a[0] * a[0] + a[1] * a[1]) + (a[2] * a[2] + a[3] * a[3]) + (b[0] * b[0] + b[1] * b[1]) + (b[2] * b[2] + b[3] * b[3]);
              v4u w; w.x = cvtpk(a[0], a[1]); w.y = cvtpk(a[2], a[3]); w.z = cvtpk(b[0], b[1]); w.w = cvtpk(b[2], b[3]);
              *(v4u*)(ws + WS_XBF + ((size_t)row * D + 512 * j + 8 * lane) * 2) = w;
              v2u w8; w8.x = pk4_fp8(a * S_X); w8.y = pk4_fp8(b * S_X); *(v2u*)(ws + WS_XB8 + (size_t)row * D + 512 * j + 8 * lane) = w8; }
          s = wave_sum(s); if (lane == 0) ss1[row] = s; } }
    { LAS float* scr = (LAS float*)(lds + wave * 16384);
      constexpr int I_IN = (D / 64) * (10240 / 32), I_GT = (D / 64) * (GWD / 32), I_AP = (AW / 64) * (D / 32), I_SP = I_AP, I_WO = (D / 64) * (D / 32);
      constexpr int NIT = I_IN + I_GT + I_AP + I_SP + I_WO;
      for (int it = gw; it < NIT; it += NGW) { int r = it;
          if (r < I_IN) { const int nb = r % (10240 / 32);
#if ZUZV_FP8
              (void)nb; p0_transpose_item8(p.w_in, D, 10240, ws + WS_W18, 0, 1, p.norm_mix_g, S_W1, scr, r, lane);
#else
              if (nb * 32 < 6144) p0_transpose_item8(p.w_in, D, 10240, ws + WS_W18, 0, 1, p.norm_mix_g, S_W1, scr, r, lane);
              else p0_transpose_item(p.w_in, D, 10240, (bf16*)(ws + WS_W1Z), -6144, 0, p.norm_mix_g, scr, r, lane);
#endif
              continue; } r -= I_IN;
          if (r < I_GT) { p0_transpose_item8(p.w_gate, D, GWD, ws + WS_W18, ZUZV_FP8 ? 10240 : 6144, 0, p.norm_mix_g, S_W1, scr, r, lane); continue; } r -= I_GT;
          if (r < I_AP) { p0_transpose_item8(p.w_attn_proj, AW, D, ws + WS_WAP, 0, 0, nullptr, S_WAP, scr, r, lane); continue; } r -= I_AP;
          if (r < I_SP) { if (SGU_FP8) p0_transpose_item8(p.w_sgu_proj, AW, D, ws + WS_WSP, 0, 0, nullptr, S_WSP, scr, r, lane); else p0_transpose_item(p.w_sgu_proj, AW, D, (bf16*)(ws + WS_WSP), 0, 0, nullptr, scr, r, lane); continue; } r -= I_SP;
          p0_transpose_item8(p.w_o, D, D, ws + WS_WO, 0, 0, nullptr, S_WO, scr, r, lane); } }
    { bf16* W2 = (bf16*)(ws + WS_W2);
      for (int it = gw; it < 16 * 128; it += NGW) { const int g16 = it >> 7, k0 = (it & 127) * 32, hh = lane >> 5, c = lane & 31;
          const float* wp = p.peer_wq + (size_t)(k0 + c) * 2048 + g16 * 128 + 8 * hh; bf16x8 Bf[8];
#pragma unroll
          for (int s = 0; s < 8; ++s) Bf[s] = pack8(*(const f32x4*)(wp + 16 * s), *(const f32x4*)(wp + 16 * s + 4));
          float gf = p.norm_ffn_g[k0 + c]; PIN(gf);
          for (int nt = 0; nt < 4; ++nt) { f32x16 acc = {};
              const float* sp = p.peer_subkeys + ((size_t)g16 * 128 + nt * 32 + c) * 128 + 8 * hh;
#pragma unroll
              for (int s = 0; s < 8; ++s) { f32x4 a0 = *(const f32x4*)(sp + 16 * s), a1 = *(const f32x4*)(sp + 16 * s + 4); PIN(a0); PIN(a1); acc = MFMA32(pack8(a0, a1), Bf[s], acc); }
              VM_WAIT();
#pragma unroll
              for (int r = 0; r < 16; ++r) { const int n = nt * 32 + (r & 3) + 8 * (r >> 2) + 4 * hh;
                  W2[(size_t)(g16 * 128 + n) * D + k0 + c] = (bf16)(cvtpk(acc[r] * gf, 0.f) & 0xffffu); } } } }
    { float* cosT = (float*)(ws + WS_COS); float* sinT = (float*)(ws + WS_SIN);
      for (int i = blockIdx.x * 512 + tid; i < T * 64; i += gridDim.x * 512) { const int t = i >> 6, f = i & 63;
          const float inv = exp2f(-(float)f * 0.20762050593046014f);
          const float ang = (float)t * inv;
          double rev = (double)ang * 0.15915494309189535; rev -= __builtin_rint(rev);
          const float fr = (float)rev;
          cosT[i] = __builtin_amdgcn_cosf(fr); sinT[i] = __builtin_amdgcn_sinf(fr); } }
}

__device__ __forceinline__ bool better(float a, int ja, float b, int jb) { return a > b || (a == b && ja < jb); }
__device__ __forceinline__ void top3_insert(float v, int j, float& v0, int& j0, float& v1, int& j1, float& v2, int& j2) {
    const bool b0 = better(v, j, v0, j0), b1 = better(v, j, v1, j1), b2 = better(v, j, v2, j2);
    v2 = b1 ? v1 : (b2 ? v : v2); j2 = b1 ? j1 : (b2 ? j : j2);
    v1 = b0 ? v0 : (b1 ? v : v1); j1 = b0 ? j0 : (b1 ? j : j1);
    v0 = b0 ? v : v0; j0 = b0 ? j : j0;
}
__device__ __forceinline__ size_t list_off(int h, int j) { return (size_t)h * LIST_HEAD_STRIDE + (size_t)256 * (63 * j - (j * (j - 1)) / 2); }
template <int NU>
__device__ __forceinline__ void moba_select_multi(const Params& p, int u0, int ustep, int lane, int wave) {
    unsigned char* ws = p.ws;
    const bf16* Q = (const bf16*)(ws + WS_Q); const float* kacc = (const float*)(ws + CB_KACC);
    unsigned* cnt = (unsigned*)(ws + CB_CNT); unsigned* list = (unsigned*)(ws + WS_LIST); f32x2* ML = (f32x2*)(ws + WS_ML);
    const int hh = lane >> 5, c = lane & 31;
    const float NINF = -__builtin_inff();
    float v0[NU], v1[NU], v2[NU]; int j0[NU], j1[NU], j2[NU]; bf16x8 qf[NU][8]; unsigned pos[NU][3];
#pragma unroll
    for (int i = 0; i < NU; ++i) { const int u = u0 + i * ustep; const int b = u & 63, h = u >> 6, t = b * BLK + wave * 32 + c;
        v0[i] = NINF; v1[i] = NINF; v2[i] = NINF; j0[i] = 1000; j1[i] = 1001; j2[i] = 1002;
        if (u < 1024 && b > 0) { const unsigned char* qp = (const unsigned char*)Q + (size_t)t * AW + h * HD + 8 * hh; v2u qraw[8];
#pragma unroll
            for (int s = 0; s < 8; ++s) qraw[s] = *(const v2u*)(qp + 16 * s);
#pragma unroll
            for (int s = 0; s < 8; ++s) qf[i][s] = fp8x8_to_bf16(qraw[s]); } }
#pragma unroll
    for (int i = 0; i < NU; ++i) { const int u = u0 + i * ustep; const int b = u & 63, h = u >> 6;
        if (u < 1024 && b > 0) {
#pragma unroll
            for (int jt = 0; jt < 2; ++jt) if (32 * jt < b) { f32x16 g = {};
                const float* kp = kacc + ((size_t)h * 64 + 32 * jt + c) * 128 + 8 * hh;
#pragma unroll
                for (int s = 0; s < 8; ++s) g = MFMA32(pack8(*(const f32x4*)(kp + 16 * s), *(const f32x4*)(kp + 16 * s + 4)), qf[i][s], g);
#pragma unroll
                for (int r = 0; r < 16; ++r) { const int j = 32 * jt + (r & 3) + 8 * (r >> 2) + 4 * hh; top3_insert(j < b ? g[r] : NINF, j, v0[i], j0[i], v1[i], j1[i], v2[i], j2[i]); } }
            const float pv0 = __shfl_xor(v0[i], 32), pv1 = __shfl_xor(v1[i], 32), pv2 = __shfl_xor(v2[i], 32);
            const int pj0 = __shfl_xor(j0[i], 32), pj1 = __shfl_xor(j1[i], 32), pj2 = __shfl_xor(j2[i], 32);
            top3_insert(pv0, pj0, v0[i], j0[i], v1[i], j1[i], v2[i], j2[i]); top3_insert(pv1, pj1, v0[i], j0[i], v1[i], j1[i], v2[i], j2[i]); top3_insert(pv2, pj2, v0[i], j0[i], v1[i], j1[i], v2[i], j2[i]);
        } }
    VM_WAIT();
#pragma unroll
    for (int i = 0; i < NU; ++i) { const int u = u0 + i * ustep; const int b = u & 63, h = u >> 6; const int nsel = b < 3 ? b : 3;
#pragma unroll
        for (int r = 0; r < 3; ++r) { const int j = r == 0 ? j0[i] : (r == 1 ? j1[i] : j2[i]); pos[i][r] = 0u; if (u < 1024 && hh == 0 && r < nsel) pos[i][r] = atomicAdd(cnt + h * 64 + j, 1u); } }
    VM_WAIT();
#pragma unroll
    for (int i = 0; i < NU; ++i)
#pragma unroll
        for (int r = 0; r < 3; ++r) PIN(pos[i][r]);
#pragma unroll
    for (int i = 0; i < NU; ++i) { const int u = u0 + i * ustep; const int b = u & 63, h = u >> 6, t = b * BLK + wave * 32 + c; const int nsel = b < 3 ? b : 3;
        if (u < 1024 && hh == 0) {
#pragma unroll
            for (int r = 0; r < 3; ++r) { const int j = r == 0 ? j0[i] : (r == 1 ? j1[i] : j2[i]);
                if (r < nsel) list[list_off(h, j) + pos[i][r]] = (unsigned)t | ((unsigned)r << 14);
                else ML[((size_t)r * T + t) * 16 + h] = (f32x2){NINF, 0.f}; } } }
}
__device__ __forceinline__ void sgu_unit(const Params& p, LAS unsigned char* lds, int cch, int g, int tid, int lane, int wave) {
    unsigned char* ws = p.ws;
    const bf16* GV = (const bf16*)(ws + WS_GV); const bf16* U = (const bf16*)(ws + WS_U); bf16* SO = (bf16*)(ws + WS_SO);
    LAS float* rsq = (LAS float*)(lds + 32768);
    f32x4 wpa[8], wpb[8];
    { const int tt0 = wave >> 1, hh0 = lane >> 5, c0 = lane & 31; const float* wrow0 = p.sgu_w + ((size_t)g * 128 + 32 * tt0 + c0) * 128 + 8 * hh0;
#pragma unroll
      for (int ks = 0; ks < 8; ++ks) if (ks < 2 * tt0 + 2) { wpa[ks] = *(const f32x4*)(wrow0 + 16 * ks); wpb[ks] = *(const f32x4*)(wrow0 + 16 * ks + 4); } }
    v4u gvw[4]; unsigned short uraw[2][16]; float bb[16], ngv[2];
#pragma unroll
    for (int i = 0; i < 4; ++i) { const int id = tid + 512 * i, row = id >> 4, ch = id & 15; gvw[i] = *(const v4u*)(GV + (size_t)(cch * 128 + row) * AW + g * 128 + ch * 8); }
    { const int tt0 = wave >> 1, dt00 = (wave & 1) * 2, hh0 = lane >> 5, c0 = lane & 31;
#pragma unroll
      for (int r = 0; r < 16; ++r) { const int tl = 32 * tt0 + (r & 3) + 8 * (r >> 2) + 4 * hh0; bb[r] = p.sgu_b[g * 128 + tl];
#pragma unroll
          for (int d2 = 0; d2 < 2; ++d2) uraw[d2][r] = *(const unsigned short*)(U + (size_t)(cch * 128 + tl) * AW + g * 128 + 32 * (dt00 + d2) + c0); }
#pragma unroll
      for (int d2 = 0; d2 < 2; ++d2) ngv[d2] = p.sgu_norm_g[g * 128 + 32 * (dt00 + d2) + c0]; }
    __syncthreads();
    VM_WAIT();
#pragma unroll
    for (int i = 0; i < 4; ++i) { const int id = tid + 512 * i, row = id >> 4, ch = id & 15;
        v4u w = gvw[i]; PIN(w);
        *(LAS v4u*)(lds + offb(row, ch)) = w;
        float s = bflo(w.x) * bflo(w.x) + bfhi(w.x) * bfhi(w.x) + bflo(w.y) * bflo(w.y) + bfhi(w.y) * bfhi(w.y)
                + bflo(w.z) * bflo(w.z) + bfhi(w.z) * bfhi(w.z) + bflo(w.w) * bflo(w.w) + bfhi(w.w) * bfhi(w.w);
        s += __shfl_xor(s, 1); s += __shfl_xor(s, 2); s += __shfl_xor(s, 4); s += __shfl_xor(s, 8);
        if (ch == 0) rsq[row] = rsqrtf(s * (1.0f / 128.0f) + EPS); }
    __syncthreads();
    const int tt = wave >> 1, dt0 = (wave & 1) * 2, hh = lane >> 5, c = lane & 31;
    const int blk = (lane >> 4) & 1, q4 = (lane & 15) >> 2, pp = lane & 3;
    f32x16 acc[2] = {};
    const float* wrow = p.sgu_w + ((size_t)g * 128 + 32 * tt + c) * 128 + 8 * hh;
    const unsigned lbase = (unsigned)(uintptr_t)lds;
    VM_WAIT();
#pragma unroll
    for (int ks = 0; ks < 8; ++ks) if (ks < 2 * tt + 2) {
        const int s0 = 16 * ks + 8 * hh, trow = 32 * tt + c;
        f32x4 wa = wpa[ks], wb = wpb[ks]; PIN(wa); PIN(wb);
        const f32x4 ra = *(const LAS f32x4*)(rsq + s0), rb = *(const LAS f32x4*)(rsq + s0 + 4);
#pragma unroll
        for (int e = 0; e < 4; ++e) { wa[e] = (s0 + e <= trow) ? wa[e] * ra[e] : 0.f; wb[e] = (s0 + 4 + e <= trow) ? wb[e] * rb[e] : 0.f; }
        const bf16x8 A = pack8(wa, wb);
#pragma unroll
        for (int d2 = 0; d2 < 2; ++d2) { const int dt = dt0 + d2;
            const bf16x8 B = tr_read2(lbase + offb(16 * ks + 8 * hh + q4, 4 * dt + 2 * blk + (pp >> 1)) + 8 * (pp & 1),
                                      lbase + offb(16 * ks + 8 * hh + 4 + q4, 4 * dt + 2 * blk + (pp >> 1)) + 8 * (pp & 1));
            acc[d2] = MFMA32(A, B, acc[d2]); }
    }
#pragma unroll
    for (int d2 = 0; d2 < 2; ++d2) { const int d = 32 * (dt0 + d2) + c; float ng = ngv[d2]; PIN(ng);
        float uu[16];
#pragma unroll
        for (int r = 0; r < 16; ++r) { unsigned ur = uraw[d2][r]; PIN(ur); PIN(bb[r]); uu[r] = __uint_as_float(ur << 16); }
#pragma unroll
        for (int r = 0; r < 16; ++r) { const int tl = 32 * tt + (r & 3) + 8 * (r >> 2) + 4 * hh;
            const size_t o = (size_t)(cch * 128 + tl) * AW + g * 128 + d;
#ifndef PROBE_WV
#define PROBE_WV 1.0f
#endif
#if SGU_FP8
            ((unsigned char*)SO)[o] = (unsigned char)(__builtin_amdgcn_cvt_pk_fp8_f32(clamp448(uu[r] * (PROBE_WV * acc[d2][r] * ng + bb[r]) * S_SO), 0.f, 0, false) & 0xff); } }
#else
            SO[o] = (bf16)(cvtpk(uu[r] * (PROBE_WV * acc[d2][r] * ng + bb[r]), 0.f) & 0xffffu); } }
#endif
}

__device__ __forceinline__ pg8::i32x8 cat8(v4u a, v4u b) { return (pg8::i32x8){(int)a.x, (int)a.y, (int)a.z, (int)a.w, (int)b.x, (int)b.y, (int)b.z, (int)b.w}; }
#define MFMA64(A, B, C) __builtin_amdgcn_mfma_scale_f32_32x32x64_f8f6f4((A), (B), (C), 0, 0, 0, 0x7f7f7f7f, 0, 0x7f7f7f7f)
__device__ __forceinline__ void attn_item(const Params& p, LAS unsigned char* lds, int h, int jblk, bool own, const unsigned* lst, int cnt, int ti, bool newkv, int tid, int lane, int wave) {
    unsigned char* ws = p.ws;
    const unsigned char* Q = ws + WS_Q; const unsigned char* Kg = ws + WS_K + (size_t)(jblk * BLK) * AW + h * HD; const unsigned char* Vg = ws + WS_V + (size_t)(jblk * BLK) * AW + h * HD;
    f32x2* ML = (f32x2*)(ws + WS_ML);
    asm volatile("" : "+v"(lane));
    const int hh = lane >> 5, c = lane & 31;
    constexpr unsigned VT0 = 32768u;
    if (newkv) {
        __syncthreads();
        v4u kr[4], vr[4];
        const int vg4 = 4 * (tid & 63), vch = tid >> 6;
#pragma unroll
        for (int i = 0; i < 4; ++i) { const int id = tid + 512 * i, row = id >> 3, ch = id & 7; kr[i] = *(const v4u*)(Kg + (size_t)row * AW + ch * 16); vr[i] = *(const v4u*)(Vg + (size_t)(vg4 + i) * AW + vch * 16); }
#pragma unroll
        for (int i = 0; i < 4; ++i) { const int id = tid + 512 * i, row = id >> 3, ch = id & 7; *(LAS v4u*)(lds + row * 128 + 16 * (ch ^ ((row >> 1) & 7))) = kr[i]; }
        { const int kk = vg4 & 31, pos = 64 * (vg4 >> 6) + 32 * ((kk >> 2) & 1) + 16 * ((vg4 >> 5) & 1) + 4 * (kk >> 3);
          LAS unsigned char* vt = lds + VT0 + (16 * vch) * 256 + (pos & 15);
#pragma unroll
          for (int q4 = 0; q4 < 4; ++q4) {
              const unsigned k0 = q4 == 0 ? vr[0].x : (q4 == 1 ? vr[0].y : (q4 == 2 ? vr[0].z : vr[0].w)), k1 = q4 == 0 ? vr[1].x : (q4 == 1 ? vr[1].y : (q4 == 2 ? vr[1].z : vr[1].w));
              const unsigned k2 = q4 == 0 ? vr[2].x : (q4 == 1 ? vr[2].y : (q4 == 2 ? vr[2].z : vr[2].w)), k3 = q4 == 0 ? vr[3].x : (q4 == 1 ? vr[3].y : (q4 == 2 ? vr[3].z : vr[3].w));
              const unsigned t0 = __builtin_amdgcn_perm(k1, k0, 0x05010400u), t1 = __builtin_amdgcn_perm(k1, k0, 0x07030602u), t2 = __builtin_amdgcn_perm(k3, k2, 0x05010400u), t3 = __builtin_amdgcn_perm(k3, k2, 0x07030602u);
              const unsigned d0 = __builtin_amdgcn_perm(t2, t0, 0x05040100u), d1 = __builtin_amdgcn_perm(t2, t0, 0x07060302u), d2 = __builtin_amdgcn_perm(t3, t1, 0x05040100u), d3 = __builtin_amdgcn_perm(t3, t1, 0x07060302u);
              const int b0 = 4 * q4;
              *(LAS unsigned*)(vt + (b0 + 0) * 256 + 16 * ((pos >> 4) ^ (b0 + 0))) = d0; *(LAS unsigned*)(vt + (b0 + 1) * 256 + 16 * ((pos >> 4) ^ (b0 + 1))) = d1;
              *(LAS unsigned*)(vt + (b0 + 2) * 256 + 16 * ((pos >> 4) ^ (b0 + 2))) = d2; *(LAS unsigned*)(vt + (b0 + 3) * 256 + 16 * ((pos >> 4) ^ (b0 + 3))) = d3; } } }
    int t, slot; bool valid;
    if (own) { t = jblk * BLK + wave * 32 + c; slot = 3; valid = true; }
    else { const int qi = ti * 256 + wave * 32 + c; valid = qi < cnt; const unsigned e = lst[valid ? qi : 0]; t = (int)(e & 16383u); slot = (int)(e >> 14); }
    const bool wactive = own || (ti * 256 + wave * 32 < cnt);
    pg8::i32x8 qf8[2];
    { const unsigned char* qp = Q + (size_t)t * AW + h * HD + 32 * hh;
#pragma unroll
      for (int cq = 0; cq < 2; ++cq) qf8[cq] = cat8(*(const v4u*)(qp + 64 * cq), *(const v4u*)(qp + 64 * cq + 16)); }
    if (newkv) __syncthreads();
    if (!wactive) return;
    const float NINF = -__builtin_inff();
    f32x16 sc[8];
#pragma unroll
    for (int kt = 0; kt < 8; ++kt) {
        sc[kt] = (f32x16){};
        if (!own || kt <= wave) { const int key = 32 * kt + c, sw = (key >> 1) & 7;
#pragma unroll
            for (int cq = 0; cq < 2; ++cq) { const int c0 = 4 * cq + 2 * hh;
                const pg8::i32x8 kf = cat8(*(const LAS v4u*)(lds + key * 128 + 16 * (c0 ^ sw)), *(const LAS v4u*)(lds + key * 128 + 16 * ((c0 + 1) ^ sw)));
                sc[kt] = MFMA64(kf, qf8[cq], sc[kt]); }
        }
    }
    if (own) {
#pragma unroll
        for (int kt = 0; kt < 8; ++kt) {
            if (kt == wave) {
#pragma unroll
                for (int r = 0; r < 16; ++r) { const int kl = (r & 3) + 8 * (r >> 2) + 4 * hh; if (kl > c) sc[kt][r] = NINF; }
            } else if (kt > wave) {
#pragma unroll
                for (int r = 0; r < 16; ++r) sc[kt][r] = NINF;
            }
        }
    }
    float mx = NINF;
#pragma unroll
    for (int kt = 0; kt < 8; ++kt)
#pragma unroll
        for (int r = 0; r < 16; ++r) mx = fmaxf(mx, sc[kt][r]);
    mx = fmaxf(mx, __shfl_xor(mx, 32));
    constexpr float C = 0.08838834764831845f * 1.4426950408889634f / (S_QKV * S_QKV);
    constexpr float S_P = 128.0f;
    const float mC = mx * C, mCs = mC - 7.0f; float ls = 0.f;
    pg8::i32x8 pf8[4];
#pragma unroll
    for (int kt = 0; kt < 8; ++kt) {
#pragma unroll
        for (int r = 0; r < 16; ++r) { const float e = __builtin_amdgcn_exp2f(sc[kt][r] * C - mCs); sc[kt][r] = e; ls += e; }
#pragma unroll
        for (int j = 0; j < 4; ++j) { int w = 0; w = __builtin_amdgcn_cvt_pk_fp8_f32(sc[kt][4 * j], sc[kt][4 * j + 1], w, false); w = __builtin_amdgcn_cvt_pk_fp8_f32(sc[kt][4 * j + 2], sc[kt][4 * j + 3], w, true); pf8[kt >> 1][4 * (kt & 1) + j] = w; }
    }
    ls += __shfl_xor(ls, 32);
    int l3 = lane; asm volatile("" : "+v"(l3), "+v"(ls));
    const int c3 = l3 & 31, hh3 = l3 >> 5;
    f32x16 o[4] = {};
#pragma unroll
    for (int pq = 0; pq < 4; ++pq) {
        if (!own || 2 * pq <= wave) {
#pragma unroll
            for (int dt = 0; dt < 4; ++dt) { const int d = 32 * dt + c3, c0 = 4 * pq + 2 * hh3, sw = c3 & 15;
                const pg8::i32x8 vf = cat8(*(const LAS v4u*)(lds + VT0 + d * 256 + 16 * (c0 ^ sw)), *(const LAS v4u*)(lds + VT0 + d * 256 + 16 * ((c0 + 1) ^ sw)));
                o[dt] = MFMA64(vf, pf8[pq], o[dt]); }
        }
    }
    VM_WAIT();
    { const float inv = S_OP / (ls * S_QKV); unsigned char* rowp = (unsigned char*)(ws + WS_OP) + ((((size_t)slot * T + t) * 16 + h) * 128) + (hh ? 16 : 0);
#pragma unroll
      for (int dt = 0; dt < 4; ++dt) { unsigned g0, g1, g2, g3;
          g0 = pk4_fp8((f32x4){o[dt][0], o[dt][1], o[dt][2], o[dt][3]} * inv); g1 = pk4_fp8((f32x4){o[dt][4], o[dt][5], o[dt][6], o[dt][7]} * inv);
          g2 = pk4_fp8((f32x4){o[dt][8], o[dt][9], o[dt][10], o[dt][11]} * inv); g3 = pk4_fp8((f32x4){o[dt][12], o[dt][13], o[dt][14], o[dt][15]} * inv);
          { const auto r = __builtin_amdgcn_permlane32_swap(g0, g1, false, false); g0 = r[0]; g1 = r[1]; }
          { const auto r = __builtin_amdgcn_permlane32_swap(g2, g3, false, false); g2 = r[0]; g3 = r[1]; }
          { const auto r = __builtin_amdgcn_permlane32_swap(g0, g2, false, false); g0 = r[0]; g2 = r[1]; }
          { const auto r = __builtin_amdgcn_permlane32_swap(g1, g3, false, false); g1 = r[0]; g3 = r[1]; }
          if (valid) *(v4u*)(rowp + 32 * dt) = (v4u){g0, g1, g2, g3}; }
      if (valid && hh == 0) ML[((size_t)slot * T + t) * 16 + h] = (f32x2){mC, ls * (1.0f / S_P)}; }
}
__device__ __forceinline__ void attn_phase(const Params& p, LAS unsigned char* lds, int tid, int lane, int wave) {
    unsigned char* ws = p.ws;
    const unsigned* cntg = (const unsigned*)(ws + CB_CNT); const unsigned* list = (const unsigned*)(ws + WS_LIST);
    LAS int* pre = (LAS int*)(lds + LDS_PRE); LAS int* wsum = (LAS int*)(lds + LDS_MISC) + 16;
    { const int a = (int)((cntg[2 * tid] + 255u) >> 8) + 1, b2 = (int)((cntg[2 * tid + 1] + 255u) >> 8) + 1, s = a + b2; int x = s;
#pragma unroll
      for (int o = 1; o < 64; o <<= 1) { const int y = __shfl_up(x, o); if (lane >= o) x += y; }
      if (lane == 63) wsum[wave] = x;
      __syncthreads();
      int woff = 0;
      for (int w = 0; w < wave; ++w) woff += wsum[w];
      const int ex = woff + x - s; pre[2 * tid] = ex; pre[2 * tid + 1] = ex + a;
      __syncthreads(); }
    int nitems = 0;
    for (int w = 0; w < NWAVES; ++w) nitems += wsum[w];
    const int i0 = (int)(((long long)nitems * (int)blockIdx.x) / (int)gridDim.x), i1 = (int)(((long long)nitems * ((int)blockIdx.x + 1)) / (int)gridDim.x);
    int cur = -1;
    for (int it = i0; it < i1; ++it) {
        int lo = 0, hi = 1023;
        while (lo < hi) { const int mid = (lo + hi + 1) >> 1; if (pre[mid] <= it) lo = mid; else hi = mid - 1; }
        const int h = lo >> 6, j = lo & 63, ti = it - pre[lo], cnt = (int)cntg[lo]; const bool newkv = lo != cur; cur = lo;
        if (ti == ((cnt + 255) >> 8)) attn_item(p, lds, h, j, true, nullptr, 0, 0, newkv, tid, lane, wave);
        else attn_item(p, lds, h, j, false, list + list_off(h, j), cnt, ti, newkv, tid, lane, wave);
    }
}
__device__ __forceinline__ void attn_combine(const Params& p, int lane, int wave) {
    unsigned char* ws = p.ws;
    const unsigned char* OP = ws + WS_OP; const f32x2* ML = (const f32x2*)(ws + WS_ML); unsigned char* AO8 = ws + WS_AO8;
    const int gw = blockIdx.x * NWAVES + wave, NGW = gridDim.x * NWAVES;
    for (int i0 = gw; i0 < T * 4; i0 += 4 * NGW) {
        f32x2 ml[4][4]; v2u ov4[4][4];
#pragma unroll
        for (int q = 0; q < 4; ++q) { const int i = i0 + q * NGW; if (i < T * 4) { const int t = i >> 2, h = (i & 3) * 4 + (lane >> 4), d0 = (lane & 15) * 8;
#pragma unroll
            for (int s = 0; s < 4; ++s) { ml[q][s] = ML[((size_t)s * T + t) * 16 + h]; ov4[q][s] = *(const v2u*)(OP + (((size_t)s * T + t) * 16 + h) * 128 + d0); } } }
        VM_WAIT();
#pragma unroll
        for (int q = 0; q < 4; ++q)
#pragma unroll
            for (int s = 0; s < 4; ++s) { PIN(ml[q][s]); PIN(ov4[q][s]); }
#pragma unroll
        for (int q = 0; q < 4; ++q) { const int i = i0 + q * NGW; if (i < T * 4) { const int t = i >> 2, h = (i & 3) * 4 + (lane >> 4), d0 = (lane & 15) * 8;
            float M = -__builtin_inff();
#pragma unroll
            for (int s = 0; s < 4; ++s) { if (ml[q][s].y > 0.f) M = fmaxf(M, ml[q][s].x); }
            float w[4], W = 0.f;
#pragma unroll
            for (int s = 0; s < 4; ++s) { w[s] = ml[q][s].y > 0.f ? ml[q][s].y * __builtin_amdgcn_exp2f(ml[q][s].x - M) : 0.f; W += w[s]; }
            const float iW = 1.0f / W; float acc[8] = {0.f, 0.f, 0.f, 0.f, 0.f, 0.f, 0.f, 0.f};
#pragma unroll
            for (int s = 0; s < 4; ++s) { const v2u v = ov4[q][s]; const float ww = w[s] * iW * (1.0f / S_OP);
                if (ww > 0.f) { const f32x2 p0 = __builtin_amdgcn_cvt_pk_f32_fp8((int)v.x, false), p1 = __builtin_amdgcn_cvt_pk_f32_fp8((int)v.x, true), p2 = __builtin_amdgcn_cvt_pk_f32_fp8((int)v.y, false), p3 = __builtin_amdgcn_cvt_pk_f32_fp8((int)v.y, true);
                                acc[0] += ww * p0.x; acc[1] += ww * p0.y; acc[2] += ww * p1.x; acc[3] += ww * p1.y; acc[4] += ww * p2.x; acc[5] += ww * p2.y; acc[6] += ww * p3.x; acc[7] += ww * p3.y; } }
            v2u o; o.x = pk4_fp8((f32x4){acc[0], acc[1], acc[2], acc[3]} * S_AO); o.y = pk4_fp8((f32x4){acc[4], acc[5], acc[6], acc[7]} * S_AO);
            *(v2u*)(AO8 + (size_t)t * AW + h * HD + d0) = o; } }
    }
}
constexpr float PEER_SU = 128.0f, PEER_SV = 4.0f;
constexpr int PEER_ROWB = 2048;
__device__ __forceinline__ float clamp6(float x) { return fminf(fmaxf(x, -6.0f), 6.0f); }
__device__ __forceinline__ void peer_pack_row_piece4(const float* src, const f32x4 (&g)[4][4], float scale, unsigned char* dst, int L) {
    unsigned w[8]; f32x4 v[4][4];
#pragma unroll
    for (int c = 0; c < 4; ++c)
#pragma unroll
        for (int j = 0; j < 4; ++j) v[c][j] = *(const f32x4*)(src + 1024 * c + 16 * L + 4 * j);
    VM_WAIT();
#pragma unroll
    for (int c = 0; c < 4; ++c) {
#pragma unroll
        for (int j = 0; j < 4; ++j) PIN(v[c][j]);
#pragma unroll
        for (int j = 0; j < 4; ++j)
#pragma unroll
            for (int e = 0; e < 4; ++e) v[c][j][e] = clamp6(v[c][j][e] * g[c][j][e] * scale);
#pragma unroll
        for (int d = 0; d < 2; ++d) { unsigned x = 0;
            x = __builtin_amdgcn_cvt_scalef32_pk_fp4_f32(x, v[c][2 * d][0], v[c][2 * d][1], 1.0f, 0); x = __builtin_amdgcn_cvt_scalef32_pk_fp4_f32(x, v[c][2 * d][2], v[c][2 * d][3], 1.0f, 1);
            x = __builtin_amdgcn_cvt_scalef32_pk_fp4_f32(x, v[c][2 * d + 1][0], v[c][2 * d + 1][1], 1.0f, 2); x = __builtin_amdgcn_cvt_scalef32_pk_fp4_f32(x, v[c][2 * d + 1][2], v[c][2 * d + 1][3], 1.0f, 3);
            w[2 * c + d] = x; }
    }
    *(v4u*)(dst + 16 * L) = (v4u){w[0], w[1], w[2], w[3]}; *(v4u*)(dst + 1024 + 16 * L) = (v4u){w[4], w[5], w[6], w[7]};
}
__device__ __forceinline__ void peer_tables(const Params& p, int tid) {
    unsigned char* ws = p.ws; unsigned char* TU = ws + WS_TU; unsigned char* TV = ws + WS_TV;
    const int L = tid & 63;
    f32x4 gu[4][4], g1[4][4];
#pragma unroll
    for (int c = 0; c < 4; ++c)
#pragma unroll
        for (int j = 0; j < 4; ++j) { gu[c][j] = *(const f32x4*)(p.norm_ffn_g + 1024 * c + 16 * L + 4 * j); g1[c][j] = (f32x4){1.f, 1.f, 1.f, 1.f}; }
    VM_WAIT();
#pragma unroll
    for (int c = 0; c < 4; ++c)
#pragma unroll
        for (int j = 0; j < 4; ++j) PIN(gu[c][j]);
    for (size_t i = (size_t)blockIdx.x * 512 + tid; i < (size_t)16384 * 64; i += (size_t)gridDim.x * 512) { const size_t e = i >> 6;
        peer_pack_row_piece4(p.peer_u + e * D, gu, PEER_SU, TU + e * PEER_ROWB, L);
        peer_pack_row_piece4(p.peer_v + e * D, g1, PEER_SV, TV + e * PEER_ROWB, L); }
}
#ifndef PROBE_SKIP_PEER
#define PROBE_SKIP_PEER 0
#endif
#ifndef PROBE_SP
#define PROBE_SP 1.0f
#endif
__device__ __forceinline__ int f2ord(float f) { const int b = __float_as_int(f); return b ^ ((b >> 31) & 0x7fffffff); }
__device__ __forceinline__ void peer_phase(const Params& p, LAS unsigned char* lds, int lane, int wave, bool dry = false, int pmode = 0) {
    unsigned char* ws = p.ws;
    const float* S = (const float*)(ws + WS_S); const float* ss2 = (const float*)(ws + WS_SS2);
    const bf16* X1B = (const bf16*)(ws + WS_X1B); const unsigned char* TU = ws + WS_TU; const unsigned char* TV = ws + WS_TV;
    LAS unsigned char* wl = lds + wave * PEER_WAVE_LDS;
    LAS float* sl = (LAS float*)wl;
    LAS int* kl = (LAS int*)(wl + 8192);
    LAS int* exl = (LAS int*)(wl + 18432);
    LAS float* gtl = (LAS float*)(wl + 18432 + 512);
    const int gw = blockIdx.x * NWAVES + wave, NGW = gridDim.x * NWAVES;
    const int IMIN = (int)0x80000000;
    int ci = 0, cb = 0;
    { const int th[15] = {16, 24, 29, 33, 36, 38, 40, 42, 43, 44, 45, 46, 47, 48, 49};
#pragma unroll
      for (int k = 0; k < 15; ++k) if (lane >= th[k]) { ci = k + 1; cb = th[k]; } }
    const int cj = (lane - cb) & 15; const bool cvalid = lane < 50;
    const __amdgpu_buffer_rsrc_t rsU = __builtin_amdgcn_make_buffer_rsrc((void*)TU, 0, -1, 0x00020000), rsV = __builtin_amdgcn_make_buffer_rsrc((void*)TV, 0, -1, 0x00020000);
    for (int t = gw; t < T; t += NGW) {
        const float rstd2 = rsqrtf(wave_sum(ss2[(size_t)t * 64 + lane]) * (1.0f / 4096.0f) + EPS);
#pragma unroll
        for (int c = 0; c < 8; ++c) { typedef _Float16 h4_t __attribute__((ext_vector_type(4)));
            const h4_t hv = *(const h4_t*)((const _Float16*)S + (size_t)t * 2048 + 256 * c + 4 * lane);
            const f32x4 svc = {(float)hv.x, (float)hv.y, (float)hv.z, (float)hv.w}; *(LAS f32x4*)(sl + 256 * c + 4 * lane) = svc; }
        LDS_WAIT();
#define PEER_CE(a, b) { const int hi_ = a > b ? a : b, lo_ = a > b ? b : a; a = hi_; b = lo_; }
#define PEER_POP(k, m) { const bool p_ = k[0] == m; k[0] = p_ ? k[1] : k[0]; k[1] = p_ ? k[2] : k[1]; k[2] = p_ ? k[3] : k[2]; k[3] = p_ ? IMIN : k[3]; }
#pragma unroll 1
        for (int c2 = 0; c2 < 4; ++c2) {
            int ka[4], kb[4]; { const int nb = 127 - 4 * (lane & 31); const f32x4 sa = *(const LAS f32x4*)(sl + 512 * c2 + 4 * lane), sb = *(const LAS f32x4*)(sl + 512 * c2 + 256 + 4 * lane);
#pragma unroll
              for (int e2 = 0; e2 < 4; ++e2) { ka[e2] = (f2ord(sa[e2]) & ~127) | (nb - e2); kb[e2] = (f2ord(sb[e2]) & ~127) | (nb - e2); } }
            PEER_CE(ka[0], ka[1]) PEER_CE(ka[2], ka[3]) PEER_CE(ka[0], ka[2]) PEER_CE(ka[1], ka[3]) PEER_CE(ka[1], ka[2])
            PEER_CE(kb[0], kb[1]) PEER_CE(kb[2], kb[3]) PEER_CE(kb[0], kb[2]) PEER_CE(kb[1], kb[3]) PEER_CE(kb[1], kb[2])
            int mineA = IMIN, mineB = IMIN;
#pragma unroll 1
            for (int it = 0; it < 16; ++it) {
                const int mA = half32_max_i(ka[0]), mB = half32_max_i(kb[0]);
                PEER_POP(ka, mA) PEER_POP(kb, mB)
                mineA = (lane & 31) == it ? mA : mineA; mineB = (lane & 31) == it ? mB : mineB;
            }
            if ((lane & 31) < 16) { kl[(4 * c2 + (lane >> 5)) * 16 + (lane & 31)] = mineA; kl[(4 * c2 + 2 + (lane >> 5)) * 16 + (lane & 31)] = mineB; }
        }
#undef PEER_CE
#undef PEER_POP
        LDS_WAIT();
#pragma unroll 1
        for (int h2 = 0; h2 < 4; ++h2) {
            int keyA, keyB;
            { const int hd = 2 * h2; const int ka = kl[(2 * hd) * 16 + ci], kb = kl[(2 * hd + 1) * 16 + cj];
              const float v = sl[(2 * hd) * 128 + 127 - (ka & 127)] + sl[(2 * hd + 1) * 128 + 127 - (kb & 127)]; keyA = cvalid ? ((f2ord(v) & ~255) | (255 - (ci * 16 + cj))) : IMIN; }
            { const int hd = 2 * h2 + 1; const int ka = kl[(2 * hd) * 16 + ci], kb = kl[(2 * hd + 1) * 16 + cj];
              const float v = sl[(2 * hd) * 128 + 127 - (ka & 127)] + sl[(2 * hd + 1) * 128 + 127 - (kb & 127)]; keyB = cvalid ? ((f2ord(v) & ~255) | (255 - (ci * 16 + cj))) : IMIN; }
            int mineA = IMIN, mineB = IMIN;
#pragma unroll 1
            for (int it = 0; it < 16; ++it) { const int mA = wave_max_fast_i(keyA), mB = wave_max_fast_i(keyB); keyA = keyA == mA ? IMIN : keyA; keyB = keyB == mB ? IMIN : keyB; mineA = lane == it ? mA : mineA; mineB = lane == it ? mB : mineB; }
#pragma unroll
            for (int q2 = 0; q2 < 2; ++q2) { const int hd = 2 * h2 + q2, mine = q2 ? mineB : mineA;
                const int fl = 255 - (mine & 255), wi = (fl >> 4) & 15, wj = fl & 15;
                const int k1 = kl[(2 * hd) * 16 + wi], k2 = kl[(2 * hd + 1) * 16 + wj];
                const int n1 = 127 - (k1 & 127), n2 = 127 - (k2 & 127);
                const float bv = sl[(2 * hd) * 128 + n1] + sl[(2 * hd + 1) * 128 + n2];
                const float bmax = __shfl(bv, 0);
                const float e = lane < 16 ? __expf((bv - bmax) * rstd2) : 0.f;
                const float es = wave_sum_fast(e);
                if (lane < 16) { exl[hd * 16 + lane] = n1 * 128 + n2; gtl[hd * 16 + lane] = e / es; } }
        }
        LDS_WAIT();
        { const int e0 = exl[lane], e1 = exl[64 + lane]; const float g0 = gtl[lane], g1 = gtl[64 + lane];
          const int k0 = e0 * 128 + lane, k1 = e1 * 128 + 64 + lane; int r0 = 0, r1 = 0;
#pragma unroll 4
          for (int i = 0; i < 128; i += 4) { const pg8::i32x4 v = *(const LAS pg8::i32x4*)(exl + i);
#pragma unroll
              for (int j = 0; j < 4; ++j) { const int ko = v[j] * 128 + i + j; r0 += ko < k0 ? 1 : 0; r1 += ko < k1 ? 1 : 0; } }
          LDS_WAIT(); asm volatile("" ::: "memory");
          exl[r0] = e0; gtl[r0] = g0; exl[r1] = e1; gtl[r1] = g1; }
        LDS_WAIT();
#if defined(PROBE_DUMP) && PROBE_DUMP == 3
        {
            float* orow = p.out + (size_t)t * D;
            for (int i = lane; i < 4096; i += 64) orow[i] = 0.f;
            orow[lane] = PROBE_DUMP_A * gtl[lane]; orow[64 + lane] = PROBE_DUMP_A * gtl[64 + lane];
            orow[128 + lane] = PROBE_DUMP_S * (float)exl[lane] * (1.0f / 16384.0f); orow[192 + lane] = PROBE_DUMP_S * (float)exl[64 + lane] * (1.0f / 16384.0f);
            if (lane == 0) orow[256] = rstd2;
            continue;
        }
#endif
        pg8::pg8_h2 oh[4][8]; v4u xq[3][2]; v4u xraw[4][2];
        { float xf[4][16];
#pragma unroll
          for (int c = 0; c < 4; ++c) { const v4u w0 = *(const v4u*)(X1B + (size_t)t * D + 1024 * c + 16 * lane), w1 = *(const v4u*)(X1B + (size_t)t * D + 1024 * c + 16 * lane + 8); xraw[c][0] = w0; xraw[c][1] = w1;
            xf[c][0] = bflo(w0.x); xf[c][1] = bfhi(w0.x); xf[c][2] = bflo(w0.y); xf[c][3] = bfhi(w0.y); xf[c][4] = bflo(w0.z); xf[c][5] = bfhi(w0.z); xf[c][6] = bflo(w0.w); xf[c][7] = bfhi(w0.w);
            xf[c][8] = bflo(w1.x); xf[c][9] = bfhi(w1.x); xf[c][10] = bflo(w1.y); xf[c][11] = bfhi(w1.y); xf[c][12] = bflo(w1.z); xf[c][13] = bfhi(w1.z); xf[c][14] = bflo(w1.w); xf[c][15] = bfhi(w1.w);
#pragma unroll
            for (int e = 0; e < 8; ++e) oh[c][e] = (pg8::pg8_h2){(_Float16)0.f, (_Float16)0.f}; }
          VM_WAIT();
#pragma unroll
          for (int c = 0; c < 4; ++c) { PIN(xraw[c][0]); PIN(xraw[c][1]); }
#define PEER_XQ(cc, d, b) { wq_ = __builtin_amdgcn_cvt_scalef32_pk_fp4_f32(wq_, clamp6(xf[cc][8 * d + 2 * b]), clamp6(xf[cc][8 * d + 2 * b + 1]), 1.0f, b); }
#define PEER_XR(cc, d, b) { const f32x2 dq_ = __builtin_amdgcn_cvt_scalef32_pk_f32_fp4(wq_, 1.0f, b); xf[cc][8 * d + 2 * b] = (xf[cc][8 * d + 2 * b] - dq_.x) * 8.0f; xf[cc][8 * d + 2 * b + 1] = (xf[cc][8 * d + 2 * b + 1] - dq_.y) * 8.0f; }
#pragma unroll
          for (int tq = 0; tq < 3; ++tq)
#pragma unroll
              for (int cc = 0; cc < 4; ++cc)
#pragma unroll
                  for (int d = 0; d < 2; ++d) { unsigned wq_ = 0;
                      PEER_XQ(cc, d, 0) PEER_XQ(cc, d, 1) PEER_XQ(cc, d, 2) PEER_XQ(cc, d, 3)
                      PEER_XR(cc, d, 0) PEER_XR(cc, d, 1) PEER_XR(cc, d, 2) PEER_XR(cc, d, 3)
                      xq[tq][cc >> 1][2 * (cc & 1) + d] = wq_; }
#undef PEER_XQ
#undef PEER_XR
        }
        const int lane16 = 16 * lane;
        const bool ondiag = ((lane & 15) >> 2) == (lane >> 4); const int drow = lane & 3;
        float dm0 = (ondiag && drow == 0) ? 1.0f : 0.0f, dm1 = (ondiag && drow == 1) ? 1.0f : 0.0f, dm2 = (ondiag && drow == 2) ? 1.0f : 0.0f, dm3 = (ondiag && drow == 3) ? 1.0f : 0.0f;
        asm volatile("" : "+v"(dm0), "+v"(dm1), "+v"(dm2), "+v"(dm3));
#define PEER_FILL(kk) do { const int eo_ = __builtin_amdgcn_readfirstlane(exl[(kk)]) * PEER_ROWB;     \
        LAS unsigned char* sl_ = wl + ((kk) & 3) * 4096; \
        __builtin_amdgcn_raw_ptr_buffer_load_lds(rsU, (LAS void*)(sl_), 16, lane16, eo_, 0, 0); __builtin_amdgcn_raw_ptr_buffer_load_lds(rsV, (LAS void*)(sl_ + 2048), 16, lane16, eo_, 0, 0); \
        __builtin_amdgcn_raw_ptr_buffer_load_lds(rsU, (LAS void*)(sl_ + 1024), 16, lane16, eo_ + 1024, 0, 0); __builtin_amdgcn_raw_ptr_buffer_load_lds(rsV, (LAS void*)(sl_ + 3072), 16, lane16, eo_ + 1024, 0, 0); } while (0)
#define PEER_V(VB, W2, q, dd, b) oh[2 * q + (dd >> 1)][4 * (dd & 1) + b] = __builtin_amdgcn_cvt_scalef32_pk_f16_fp4(VB[q][dd], 1.0f, b) * W2 + oh[2 * q + (dd >> 1)][4 * (dd & 1) + b]
#define PEER_ALLV(VB, W2) PEER_V(VB, W2, 0, 0, 0); PEER_V(VB, W2, 0, 0, 1); PEER_V(VB, W2, 0, 0, 2); PEER_V(VB, W2, 0, 0, 3); PEER_V(VB, W2, 0, 1, 0); PEER_V(VB, W2, 0, 1, 1); PEER_V(VB, W2, 0, 1, 2); PEER_V(VB, W2, 0, 1, 3); \
                          PEER_V(VB, W2, 0, 2, 0); PEER_V(VB, W2, 0, 2, 1); PEER_V(VB, W2, 0, 2, 2); PEER_V(VB, W2, 0, 2, 3); PEER_V(VB, W2, 0, 3, 0); PEER_V(VB, W2, 0, 3, 1); PEER_V(VB, W2, 0, 3, 2); PEER_V(VB, W2, 0, 3, 3); \
                          PEER_V(VB, W2, 1, 0, 0); PEER_V(VB, W2, 1, 0, 1); PEER_V(VB, W2, 1, 0, 2); PEER_V(VB, W2, 1, 0, 3); PEER_V(VB, W2, 1, 1, 0); PEER_V(VB, W2, 1, 1, 1); PEER_V(VB, W2, 1, 1, 2); PEER_V(VB, W2, 1, 1, 3); \
                          PEER_V(VB, W2, 1, 2, 0); PEER_V(VB, W2, 1, 2, 1); PEER_V(VB, W2, 1, 2, 2); PEER_V(VB, W2, 1, 2, 3); PEER_V(VB, W2, 1, 3, 0); PEER_V(VB, W2, 1, 3, 1); PEER_V(VB, W2, 1, 3, 2); PEER_V(VB, W2, 1, 3, 3)
#define PEER_DOT(UB, DG) { const pg8::i32x8 ua0 = {(int)UB[0].x, (int)UB[0].y, (int)UB[0].z, (int)UB[0].w, 0, 0, 0, 0}, ua1 = {(int)UB[1].x, (int)UB[1].y, (int)UB[1].z, (int)UB[1].w, 0, 0, 0, 0}; \
              _Pragma("unroll") for (int tq = 0; tq < 3; ++tq) { const int sc = tq == 0 ? 0x7f7f7f7f : (tq == 1 ? 0x7c7c7c7c : 0x79797979); \
                DG = __builtin_amdgcn_mfma_scale_f32_16x16x128_f8f6f4(ua0, (pg8::i32x8){(int)xq[tq][0].x, (int)xq[tq][0].y, (int)xq[tq][0].z, (int)xq[tq][0].w, 0, 0, 0, 0}, DG, 4, 4, 0, 0x7f7f7f7f, 0, sc); \
                DG = __builtin_amdgcn_mfma_scale_f32_16x16x128_f8f6f4(ua1, (pg8::i32x8){(int)xq[tq][1].x, (int)xq[tq][1].y, (int)xq[tq][1].z, (int)xq[tq][1].w, 0, 0, 0, 0}, DG, 4, 4, 0, 0x7f7f7f7f, 0, sc); } }
        const bool oddl = (lane & 1) != 0;
        if (pmode != 2) { PEER_FILL(0); PEER_FILL(1); PEER_FILL(2); PEER_FILL(3); }
#pragma unroll 1
        for (int k = 0; k < (PROBE_SKIP_PEER ? 0 : 128); k += 2) {
            if (pmode != 2) { if (k < 126) asm volatile("s_waitcnt vmcnt(8)" ::: "memory"); else asm volatile("s_waitcnt vmcnt(0)" ::: "memory"); }
            const LAS unsigned char* spA = wl + (k & 3) * 4096 + 16 * lane; const LAS unsigned char* spB = wl + ((k + 1) & 3) * 4096 + 16 * lane;
            v4u ubA[2], vbA[2], ubB[2], vbB[2];
#pragma unroll
            for (int c = 0; c < 2; ++c) { ubA[c] = *(const LAS v4u*)(spA + 1024 * c); ubB[c] = *(const LAS v4u*)(spB + 1024 * c); }
#pragma unroll
            for (int c = 0; c < 2; ++c) { vbA[c] = *(const LAS v4u*)(spA + 2048 + 1024 * c); vbB[c] = *(const LAS v4u*)(spB + 2048 + 1024 * c); }
            const float gate = gtl[k + (lane & 1)];
            LDS_WAIT();
            asm volatile("" : "+v"(vbA[0]), "+v"(vbA[1]), "+v"(vbB[0]), "+v"(vbB[1]));
            if (pmode != 2 && k < 124) { PEER_FILL(k + 4); PEER_FILL(k + 5); }
            f32x4 dgA = {0.f, 0.f, 0.f, 0.f}, dgB = {0.f, 0.f, 0.f, 0.f};
            PEER_DOT(ubA, dgA) PEER_DOT(ubB, dgB)
            asm volatile("" : "+v"(dgA), "+v"(dgB) : "v"(ubA[0]), "v"(ubA[1]), "v"(ubB[0]), "v"(ubB[1]));
            const float pA = dgA[0] * dm0 + dgA[1] * dm1 + dgA[2] * dm2 + dgA[3] * dm3, pB = dgB[0] * dm0 + dgB[1] * dm1 + dgB[2] * dm2 + dgB[3] * dm3;
            float r = (oddl ? pB : pA) + __int_as_float(DPP_I(__float_as_int(oddl ? pA : pB), 0xB1));
            r += __int_as_float(DPP_I(__float_as_int(r), 0x4E)); r += __int_as_float(DPP_I(__float_as_int(r), 0x124)); r += __int_as_float(DPP_I(__float_as_int(r), 0x128));
            { const int v = __float_as_int(r); const auto s16 = __builtin_amdgcn_permlane16_swap((unsigned)v, (unsigned)v, false, false); r = __uint_as_float(s16[0]) + __uint_as_float(s16[1]); }
            { const int v = __float_as_int(r); const auto s32 = __builtin_amdgcn_permlane32_swap((unsigned)v, (unsigned)v, false, false); r = __uint_as_float(s32[0]) + __uint_as_float(s32[1]); }
            const float wgt = PROBE_SP * gate * pg8::gelu_tanh(r * (rstd2 * (1.0f / PEER_SU))) * (1.0f / PEER_SV);
            const pg8::pg8_h2 w2 = {(_Float16)wgt, (_Float16)wgt}; const int w2i = (int)__builtin_bit_cast(unsigned, w2);
            const pg8::pg8_h2 w2A = __builtin_bit_cast(pg8::pg8_h2, (unsigned)__builtin_amdgcn_update_dpp(0, w2i, 0xA0, 0xF, 0xF, true)), w2B = __builtin_bit_cast(pg8::pg8_h2, (unsigned)__builtin_amdgcn_update_dpp(0, w2i, 0xF5, 0xF, 0xF, true));
            PEER_ALLV(vbA, w2A);
            PEER_ALLV(vbB, w2B);
        }
        asm volatile("s_waitcnt vmcnt(0)" ::: "memory");
#undef PEER_FILL
#undef PEER_V
#undef PEER_ALLV
#undef PEER_DOT
        float ov[4][16];
#pragma unroll
        for (int c = 0; c < 4; ++c)
#pragma unroll
            for (int e = 0; e < 8; ++e) { ov[c][2 * e] = (float)oh[c][e].x; ov[c][2 * e + 1] = (float)oh[c][e].y; }
        float* orow = p.out + (size_t)t * D; float sq = 0.f;
#pragma unroll
        for (int c = 0; c < 4; ++c) { f32x4 a[4];
            a[0] = (f32x4){bflo(xraw[c][0].x), bfhi(xraw[c][0].x), bflo(xraw[c][0].y), bfhi(xraw[c][0].y)}; a[1] = (f32x4){bflo(xraw[c][0].z), bfhi(xraw[c][0].z), bflo(xraw[c][0].w), bfhi(xraw[c][0].w)};
            a[2] = (f32x4){bflo(xraw[c][1].x), bfhi(xraw[c][1].x), bflo(xraw[c][1].y), bfhi(xraw[c][1].y)}; a[3] = (f32x4){bflo(xraw[c][1].z), bfhi(xraw[c][1].z), bflo(xraw[c][1].w), bfhi(xraw[c][1].w)};
#pragma unroll
            for (int j = 0; j < 4; ++j)
#pragma unroll
                for (int e = 0; e < 4; ++e) { ov[c][4 * j + e] += a[j][e]; sq += ov[c][4 * j + e] * ov[c][4 * j + e]; } }
        sq = wave_sum(sq);
        const float rf = rsqrtf(sq * (1.0f / 4096.0f) + EPS);
#pragma unroll
        for (int c = 0; c < 4; ++c) { f32x4 g[4];
#pragma unroll
            for (int j = 0; j < 4; ++j) g[j] = *(const f32x4*)(p.norm_final_g + 1024 * c + 16 * lane + 4 * j);
#pragma unroll
            for (int j = 0; j < 4; ++j) PIN(g[j]);
#pragma unroll
            for (int j = 0; j < 4; ++j) if (!dry || rf == -1.0f) *(f32x4*)(orow + 1024 * c + 16 * lane + 4 * j) = (f32x4){ov[c][4 * j] * rf * g[j][0], ov[c][4 * j + 1] * rf * g[j][1], ov[c][4 * j + 2] * rf * g[j][2], ov[c][4 * j + 3] * rf * g[j][3]}; }
    }
}

__global__ void __launch_bounds__(NWAVES * 64, 2) fwd(Params p) {
    extern __shared__ __attribute__((aligned(16))) unsigned char lds_raw[];
    LAS unsigned char* lds = (LAS unsigned char*)lds_raw;
    const int tid = threadIdx.x, lane = tid & 63, wave = __builtin_amdgcn_readfirstlane(tid >> 6);
    unsigned char* ws = p.ws;
    if (tid < 64) ((LAS unsigned*)(lds + LDS_MISC))[tid] = 0u;
#if defined(PROBE_FENCES)
    __builtin_amdgcn_fence(__ATOMIC_ACQUIRE, PROBE_SCOPE); asm volatile("s_waitcnt vmcnt(0)" ::: "memory");
#endif
    __syncthreads();
    const int lo = p.ph_lo, hi = p.ph_hi;
    XcdBarrier bar; bar.bar = (unsigned*)(ws + WS_CTL) + CW_BAR + p.li * XCD_BAR_WORDS; bar.x = 0; bar.st = nullptr;
    if (hi - lo > 1) bar = xcd_barrier_post((unsigned*)(ws + WS_CTL) + CW_BAR + p.li * XCD_BAR_WORDS, (volatile LAS unsigned*)(lds + LDS_MISC) + 8);
#define IN(k) (lo <= (k) && (k) < hi)
#define SEAM(k) do { if (IN(k) && IN((k) + 1)) xcd_barrier(bar); } while (0)
    const int G = gridDim.x;

    if (IN(0)) { p0_prologue(p, lds, tid, lane, wave); if (PROBE_DUP == 0) { xcd_barrier(bar); p0_prologue(p, lds, tid, lane, wave); } }
    SEAM(0);
    if (IN(1)) {
        const pg8::EpiIn E0{(const float*)(ws + WS_SS1), (const float*)(ws + WS_COS), (const float*)(ws + WS_SIN), p.b_gate, (float*)(ws + CB_KACC), 0, 1.0f, (bf16*)(ws + WS_Q), (bf16*)(ws + WS_G)};
        const pg8::EpiIn E1{(const float*)(ws + WS_SS1), (const float*)(ws + WS_COS), (const float*)(ws + WS_SIN), p.b_gate, (float*)(ws + CB_KACC), 1, 1.0f / (S_X * S_W1), (bf16*)(ws + WS_Q), (bf16*)(ws + WS_G)};
        static_assert(WS_K - WS_Q == (size_t)T * 2048 * 2 && WS_V - WS_K == WS_K - WS_Q && WS_U - WS_V == WS_K - WS_Q && WS_GV - WS_U == WS_K - WS_Q, "q|k|v|u|gv contiguous");
#if ZUZV_FP8
        { const pg8::EpiIn E2{(const float*)(ws + WS_SS1), (const float*)(ws + WS_COS), (const float*)(ws + WS_SIN), p.b_gate, (float*)(ws + CB_KACC), 2, 1.0f / (S_X * S_W1), (bf16*)(ws + WS_Q), (bf16*)(ws + WS_G)};
          pg8::Gemm g{(const bf16*)(ws + WS_XB8), (const bf16*)(ws + WS_W18), T, N1, D}; pg8::StaticOrder S; S.init(T, N1, G, (int)blockIdx.x);
          pg8::gemm_phase<pg8::EpiIn, pg8::StaticOrder, true, true, true>(lds, g, S, E2); (void)E0; (void)E1; }
#if PROBE_DUP == 11
          { xcd_barrier(bar); const pg8::EpiNull EN{};
            pg8::Gemm g{(const bf16*)(ws + WS_XB8), (const bf16*)(ws + WS_W18), T, N1, D}; pg8::StaticOrder S; S.init(T, N1, G, (int)blockIdx.x);
            pg8::gemm_phase<pg8::EpiNull, pg8::StaticOrder, true, true, true>(lds, g, S, EN); }
#endif
#if PROBE_DUP == 1
          { xcd_barrier(bar); const pg8::EpiIn E2{(const float*)(ws + WS_SS1), (const float*)(ws + WS_COS), (const float*)(ws + WS_SIN), p.b_gate, (float*)(ws + CB_KACC), 2, 1.0f / (S_X * S_W1), (bf16*)(ws + WS_Q), (bf16*)(ws + WS_G)};
            pg8::Gemm g{(const bf16*)(ws + WS_XB8), (const bf16*)(ws + WS_W18), T, N1, D}; pg8::StaticOrder S; S.init(T, N1, G, (int)blockIdx.x);
            pg8::gemm_phase<pg8::EpiIn, pg8::StaticOrder, true, true, true>(lds, g, S, E2); }
#endif
#else
        { pg8::Gemm g{(const bf16*)(ws + WS_XB), (const bf16*)(ws + WS_W1Z), T, 4096, D}; pg8::StaticOrder S; S.init(T, 4096, G, (int)blockIdx.x);
          pg8::gemm_phase<pg8::EpiIn, pg8::StaticOrder, true, true>(lds, g, S, E0); }
        { pg8::Gemm g{(const bf16*)(ws + WS_XB8), (const bf16*)(ws + WS_W18), T, 14336, D}; pg8::StaticOrder S; S.init(T, 14336, G, (int)blockIdx.x);
          pg8::gemm_phase<pg8::EpiIn, pg8::StaticOrder, true, true, true>(lds, g, S, E1); }
#endif
    }
    SEAM(1);
#if defined(PROBE_GATECHK)
    if (IN(2)) {
        float* accum = (float*)(ws + 147456);
        const float* ss1 = (const float*)(ws + WS_SS1); const bf16* Gm = (const bf16*)(ws + WS_G);
        const int gw2 = blockIdx.x * NWAVES + wave, NGW2 = gridDim.x * NWAVES; float num = 0.f, den = 0.f;
        for (int task = gw2; task < 128 * 128; task += NGW2) { const int t = PROBE_T0 + PROBE_TSTRIDE * (task >> 7), n = (task & 127) * 64 + lane;
            float s = 0.f; for (int k = 0; k < D; ++k) s += p.x[(size_t)t * D + k] * p.norm_mix_g[k] * p.w_gate[(size_t)k * GWD + n];
            const float rs = rsqrtf(ss1[t] * (1.0f / 4096.0f) + EPS); const float ref = 1.0f / (1.0f + __expf(-(s * rs + p.b_gate[n])));
            const float mine = __uint_as_float((unsigned)Gm[(size_t)t * GWD + (n ^ PROBE_XOR)] << 16);
            num += (mine - ref) * (mine - ref); den += ref * ref; }
        num = wave_sum(num); den = wave_sum(den);
        if (lane == 0) { atomicAdd(accum, num); atomicAdd(accum + 1, den); }
        xcd_barrier(bar);
        const float c = PROBE_K * sqrtf(__hip_atomic_load(accum, __ATOMIC_RELAXED, __HIP_MEMORY_SCOPE_AGENT) / __hip_atomic_load(accum + 1, __ATOMIC_RELAXED, __HIP_MEMORY_SCOPE_AGENT));
        for (size_t i = (size_t)blockIdx.x * 512 + tid; i < (size_t)T * D; i += (size_t)gridDim.x * 512) p.out[i] = c;
        return;
    }
#endif
    if (IN(2)) {
        for (int u = blockIdx.x; u < 1024; u += 4 * G) moba_select_multi<4>(p, u, G, lane, wave);
        for (int u = blockIdx.x; u < 2048; u += G) sgu_unit(p, lds, u >> 4, u & 15, tid, lane, wave);
        if (PROBE_DUP == 2) { xcd_barrier(bar); for (int u = blockIdx.x; u < 2048; u += G) sgu_unit(p, lds, u >> 4, u & 15, tid, lane, wave); }
    }
    SEAM(2);
    if (IN(3)) { attn_phase(p, lds, tid, lane, wave); if (PROBE_DUP == 3) { xcd_barrier(bar); attn_phase(p, lds, tid, lane, wave); } }
    SEAM(3);
    if (IN(4)) { attn_combine(p, lane, wave); peer_tables(p, tid); if (PROBE_DUP == 4) { xcd_barrier(bar); attn_combine(p, lane, wave); peer_tables(p, tid); } }
    SEAM(4);
    if (IN(5)) {
        { pg8::Gemm g{(const bf16*)(ws + WS_AO8), (const bf16*)(ws + WS_WAP), T, D, AW}; pg8::StaticOrder S; S.init(T, D, G, (int)blockIdx.x);
          pg8::EpiMix<0> E{(const bf16*)(ws + WS_G), (bf16*)(ws + WS_MIX), (bf16*)(ws + WS_X1B), 1.0f / (S_AO * S_WAP), 1.0f};
          pg8::gemm_phase<pg8::EpiMix<0>, pg8::StaticOrder, true, true, true>(lds, g, S, E); }
        { pg8::Gemm g{(const bf16*)(ws + WS_SO), (const bf16*)(ws + WS_WSP), T, D, AW}; pg8::StaticOrder S; S.init(T, D, G, (int)blockIdx.x);
          pg8::EpiMix<1> E{(const bf16*)(ws + WS_G), (bf16*)(ws + WS_MIX), (bf16*)(ws + WS_X1B), SGU_FP8 ? 1.0f / (S_SO * S_WSP) : 1.0f, S_MIX};
          pg8::gemm_phase<pg8::EpiMix<1>, pg8::StaticOrder, true, true, SGU_FP8 != 0>(lds, g, S, E); }
    #if PROBE_DUP == 567 || PROBE_DUP == 5
        xcd_barrier(bar);
        {
        { pg8::Gemm g{(const bf16*)(ws + WS_AO8), (const bf16*)(ws + WS_WAP), T, D, AW}; pg8::StaticOrder S; S.init(T, D, G, (int)blockIdx.x);
          pg8::EpiMix<0> E{(const bf16*)(ws + WS_G), (bf16*)(ws + WS_MIX), (bf16*)(ws + WS_X1B), 1.0f / (S_AO * S_WAP), 1.0f};
          pg8::gemm_phase<pg8::EpiMix<0>, pg8::StaticOrder, true, true, true>(lds, g, S, E); }
        { pg8::Gemm g{(const bf16*)(ws + WS_SO), (const bf16*)(ws + WS_WSP), T, D, AW}; pg8::StaticOrder S; S.init(T, D, G, (int)blockIdx.x);
          pg8::EpiMix<1> E{(const bf16*)(ws + WS_G), (bf16*)(ws + WS_MIX), (bf16*)(ws + WS_X1B), SGU_FP8 ? 1.0f / (S_SO * S_WSP) : 1.0f, S_MIX};
          pg8::gemm_phase<pg8::EpiMix<1>, pg8::StaticOrder, true, true, SGU_FP8 != 0>(lds, g, S, E); }
    }
#endif
    }
    SEAM(5);
#ifndef PROBE_SKIP_P6
#define PROBE_SKIP_P6 0
#endif
    if (IN(6) && !PROBE_SKIP_P6) {
        pg8::Gemm g{(const bf16*)(ws + WS_MIX), (const bf16*)(ws + WS_WO), T, D, D}; pg8::StaticOrder S; S.init(T, D, G, (int)blockIdx.x);
        pg8::EpiWo E{(const float*)(ws + WS_XBF), p.out, (bf16*)(ws + WS_X1B), (float*)(ws + WS_SS2), 1.0f / (S_MIX * S_WO)};
        #ifndef PROBE_P6_ALIGN
#define PROBE_P6_ALIGN true
#endif
#ifndef PROBE_P6_SP2
#define PROBE_P6_SP2 true
#endif
        pg8::gemm_phase<pg8::EpiWo, pg8::StaticOrder, true, true, true>(lds, g, S, E);
    #if PROBE_DUP == 567 || PROBE_DUP == 6
        xcd_barrier(bar);
        {
        pg8::Gemm g{(const bf16*)(ws + WS_MIX), (const bf16*)(ws + WS_WO), T, D, D}; pg8::StaticOrder S; S.init(T, D, G, (int)blockIdx.x);
        pg8::EpiWo E{(const float*)(ws + WS_XBF), p.out, (bf16*)(ws + WS_X1B), (float*)(ws + WS_SS2), 1.0f / (S_MIX * S_WO)};
        #ifndef PROBE_P6_ALIGN
#define PROBE_P6_ALIGN true
#endif
#ifndef PROBE_P6_SP2
#define PROBE_P6_SP2 true
#endif
        pg8::gemm_phase<pg8::EpiWo, pg8::StaticOrder, true, true, true>(lds, g, S, E);
    }
#endif
    }
    SEAM(6);
#if defined(PROBE_DUMP) && PROBE_DUMP == 8
    if (IN(PROBE_AT)) {
        const int gw2 = blockIdx.x * NWAVES + wave, NGW2 = gridDim.x * NWAVES;
        for (int t = gw2; t < T; t += NGW2) { const bf16* Ap = (const bf16*)(ws + WS_MIX) + (size_t)t * 4096; float* orow = p.out + (size_t)t * D;
            for (int i = lane; i < 4096; i += 64) orow[i] = (float)(((unsigned)Ap[i] * 2654435761u) >> 16) * (1.0f / 65536.0f); }
        return;
    }
    if (IN(8) && PROBE_AT != 8) return;
#endif
    if (IN(7)) {
        #ifndef PROBE_P7_A
#define PROBE_P7_A WS_X1B
#endif
#ifndef PROBE_P7_B
#define PROBE_P7_B WS_W2
#endif
        pg8::Gemm g{(const bf16*)(ws + PROBE_P7_A), (const bf16*)(ws + PROBE_P7_B), T, 2048, D}; pg8::StaticOrder S; S.init(T, 2048, G, (int)blockIdx.x);
        pg8::EpiS E{(float*)(ws + WS_S)};
        pg8::gemm_phase<pg8::EpiS, pg8::StaticOrder, true, true>(lds, g, S, E);
    #if PROBE_DUP == 567 || PROBE_DUP == 7
        xcd_barrier(bar);
        {
        #ifndef PROBE_P7_A
#define PROBE_P7_A WS_X1B
#endif
#ifndef PROBE_P7_B
#define PROBE_P7_B WS_W2
#endif
        pg8::Gemm g{(const bf16*)(ws + PROBE_P7_A), (const bf16*)(ws + PROBE_P7_B), T, 2048, D}; pg8::StaticOrder S; S.init(T, 2048, G, (int)blockIdx.x);
        pg8::EpiS E{(float*)(ws + WS_S)};
        pg8::gemm_phase<pg8::EpiS, pg8::StaticOrder, true, true>(lds, g, S, E);
    }
#endif
    }
    SEAM(7);
#if 0
#else
    if (IN(8)) { if (PROBE_DUP == 8) { peer_phase(p, lds, lane, wave, true, PROBE_PMODE); xcd_barrier(bar); } peer_phase(p, lds, lane, wave); }
#endif
#if defined(PROBE_FENCES)
    asm volatile("s_waitcnt vmcnt(0)" ::: "memory"); __syncthreads();
    if (tid == 0) { __builtin_amdgcn_fence(__ATOMIC_RELEASE, PROBE_SCOPE); asm volatile("s_waitcnt vmcnt(0)" ::: "memory"); }
#endif
#undef IN
#undef SEAM
}

extern "C" void kernel_launch(void* const* d_in, const int* in_sizes, int n_in, void* d_out, int out_size, void* d_ws, size_t ws_size, hipStream_t stream) {
    static int grid = 0;
    if (grid == 0) {
        if (n_in != 17 || out_size != T * D || ws_size < WS_END) { fprintf(stderr, "kernel_launch: unexpected shapes (n_in %d, out %d, ws %zu)\n", n_in, out_size, ws_size); grid = -1; return; }
        int dev = 0, cus = 0, per_cu = 0;
        if (hipGetDevice(&dev) != hipSuccess || hipDeviceGetAttribute(&cus, hipDeviceAttributeMultiprocessorCount, dev) != hipSuccess) { grid = -1; return; }
        if (hipFuncSetAttribute((const void*)fwd, hipFuncAttributeMaxDynamicSharedMemorySize, LDS_BYTES) != hipSuccess) { fprintf(stderr, "kernel_launch: hipFuncSetAttribute failed\n"); grid = -1; return; }
        if (hipOccupancyMaxActiveBlocksPerMultiprocessor(&per_cu, (const void*)fwd, NWAVES * 64, LDS_BYTES) != hipSuccess || per_cu < 1) { fprintf(stderr, "kernel_launch: occupancy query says %d\n", per_cu); (void)hipGetLastError(); per_cu = 1; }
        grid = cus;
    }
    if (grid < 0) return;
    (void)hipMemsetAsync((char*)d_ws + WS_CTL, 0, CTL_ZERO_BYTES, stream);
    Params a{};
    a.x = (const float*)d_in[0]; a.norm_mix_g = (const float*)d_in[1]; a.w_in = (const float*)d_in[2]; a.w_attn_proj = (const float*)d_in[3]; a.sgu_norm_g = (const float*)d_in[4];
    a.sgu_w = (const float*)d_in[5]; a.sgu_b = (const float*)d_in[6]; a.w_sgu_proj = (const float*)d_in[7]; a.w_gate = (const float*)d_in[8]; a.b_gate = (const float*)d_in[9];
    a.w_o = (const float*)d_in[10]; a.norm_ffn_g = (const float*)d_in[11]; a.peer_wq = (const float*)d_in[12]; a.peer_subkeys = (const float*)d_in[13]; a.peer_u = (const float*)d_in[14];
    a.peer_v = (const float*)d_in[15]; a.norm_final_g = (const float*)d_in[16];
    a.out = (float*)d_out; a.ws = (unsigned char*)d_ws;
    for (int li = 0; li < N_LAUNCH; ++li) {
        a.ph_lo = (N_LAUNCH == 1) ? 0 : li; a.ph_hi = (N_LAUNCH == 1) ? NPHASE : li + 1; a.li = li; a.pad = 0;
        hipLaunchKernelGGL(fwd, dim3(grid), dim3(NWAVES * 64), LDS_BYTES, stream, a);
#if defined(PROBE_REPEAT_P6)
        if (N_LAUNCH != 1 && li == 6) hipLaunchKernelGGL(fwd, dim3(grid), dim3(NWAVES * 64), LDS_BYTES, stream, a);
#endif
        const hipError_t le = hipPeekAtLastError();
        if (le != hipSuccess) { fprintf(stderr, "kernel_launch: launch %d failed: %s\n", li, hipGetErrorName(le)); break; }
    }
}
```

```cpp
#include <hip/hip_runtime.h>
#include <cstdio>
#include <cstdint>
namespace pg8 {
#define PG8_LAS __attribute__((address_space(3)))
typedef unsigned short bf16_t;
typedef short bf16x8 __attribute__((ext_vector_type(8)));
typedef float f32x4 __attribute__((ext_vector_type(4)));
typedef unsigned u32x4 __attribute__((ext_vector_type(4)));
constexpr int BM = 256, BK = 64, HALF = 128, HTB = HALF * BK * 2  , STAGE_BYTES = 8 * HTB, NXCD = 8, WGM = 8;

__host__ __device__ __forceinline__ int lds_byte(int r, int c) { const int st = (r >> 4) * 2 + (c >> 5), rr = r & 15, cc = c & 31, ob = rr * 64 + cc * 2; return st * 1024 + (ob ^ (((ob >> 9) & 1) << 5)); }
__host__ __device__ __forceinline__ void stage_rc(int b, int& R, int& C) { const int st = b / 1024, sb = b % 1024, swz = sb ^ (((sb >> 9) & 1) << 5); R = (st >> 1) * 16 + swz / 64; C = (st & 1) * 32 + (swz % 64) / 2; }
__host__ __device__ __forceinline__ int perm32(int rho) { const int n = rho >> 4, i = rho & 15; return 8 * (i >> 2) + 4 * n + (i & 3); }

struct Unit { int pm, pn; };
struct Gemm { const bf16_t* A; const bf16_t* Bt; int M, N, K; };

struct StaticOrder {
    int nM, nN, nwg, G, c;
    __host__ __device__ void init(int M, int N, int G_, int c_) { nM = M / BM; nN = N / BM; nwg = nM * nN; G = G_; c = c_; }
    __host__ __device__ bool next(int i, Unit& u) const {
        const long L = (long)i * G + c; if (L >= nwg) return false;
        int wgid = (int)L; { const int q = nwg / NXCD, r = nwg % NXCD, xcd = wgid % NXCD, off = wgid / NXCD; wgid = (xcd < r ? xcd * (q + 1) : r * (q + 1) + (xcd - r) * q) + off; }
        const int nig = WGM * nN, gid = wgid / nig, fm = gid * WGM, gsz = (nM - fm) < WGM ? (nM - fm) : WGM;
        u.pm = fm + ((wgid % nig) % gsz); u.pn = (wgid % nig) / gsz; return true;
    }
    __device__ __forceinline__ void a_ready(const Unit&) const {}
    __device__ __forceinline__ void done(const Unit&) const {}
};
typedef float f32x2 __attribute__((ext_vector_type(2)));
typedef __bf16 pg8_bf16x2 __attribute__((ext_vector_type(2)));
typedef _Float16 pg8_h2 __attribute__((ext_vector_type(2)));
__device__ __forceinline__ unsigned cvt_pk_bf16(float lo, float hi) { const f32x2 v = {lo, hi}; const pg8_bf16x2 r = __builtin_convertvector(v, pg8_bf16x2); return __builtin_bit_cast(unsigned, r); }

#define PG8_EPI_WAIT() asm volatile("s_waitcnt vmcnt(0)" ::: "memory")
#define PG8_PIN(v) asm volatile("s_waitcnt vmcnt(0)" : "+v"(v) : : "memory")
typedef unsigned u32x2 __attribute__((ext_vector_type(2)));
__device__ __forceinline__ unsigned pg8_pk4_fp8(f32x4 a) { int w = 0;
    w = __builtin_amdgcn_cvt_pk_fp8_f32(fminf(fmaxf(a[0], -448.f), 448.f), fminf(fmaxf(a[1], -448.f), 448.f), w, false); w = __builtin_amdgcn_cvt_pk_fp8_f32(fminf(fmaxf(a[2], -448.f), 448.f), fminf(fmaxf(a[3], -448.f), 448.f), w, true); return (unsigned)w; }
__device__ __forceinline__ float gelu_tanh(float x) {
    const float u = x * (0.7978845608f + 0.0356774081f * x * x);
    const float e = __builtin_amdgcn_exp2f(u * -2.8853900818f);
    return x * __builtin_amdgcn_rcpf(1.0f + e);
}
__device__ __forceinline__ float sigm(float z) { return __builtin_amdgcn_rcpf(1.0f + __builtin_amdgcn_exp2f(z * -1.4426950409f)); }
__device__ __forceinline__ float bf_lo(unsigned w) { return __uint_as_float(w << 16); }
__device__ __forceinline__ float bf_hi(unsigned w) { return __uint_as_float(w & 0xffff0000u); }

struct EpiIn {
    static constexpr bool PERM = true, AFTER_DRAIN = false;
    const float* ss1; const float* cosT; const float* sinT; const float* bgate; float* kacc;
    int mode; float descale;
    bf16_t *QKVUG, *G;
    __device__ __forceinline__ void operator()(const f32x4 (&acc)[2][2][4][2], const Unit& u, int wr, int wc, int fr, int fq) const {
        asm volatile("" : "+v"(fr), "+v"(fq));
        const int colt = mode == 2 ? u.pn * BM : (mode == 0 ? 6144 + u.pn * BM : (u.pn < 24 ? u.pn * BM : 10240 + (u.pn - 24) * BM)), reg = colt >> 11;
        const int row0 = u.pm * BM + wr * 64 + fr, cw = wc * 32 + 8 * fq;
        float rs[2][4];
#pragma unroll
        for (int ai = 0; ai < 2; ++ai)
#pragma unroll
            for (int m = 0; m < 4; ++m) rs[ai][m] = ss1[row0 + ai * HALF + m * 16];
#define PG8_RS_READY() do { PG8_EPI_WAIT(); _Pragma("unroll") for (int ai = 0; ai < 2; ++ai) _Pragma("unroll") for (int m = 0; m < 4; ++m) { PG8_PIN(rs[ai][m]); rs[ai][m] = rsqrtf(rs[ai][m] * (1.0f / 4096.0f) + 1e-6f) * descale; } } while (0)
        if (reg <= 1) {
            bf16_t* dst = QKVUG + (size_t)reg * ((size_t)16384 * 2048); const int colh = colt - reg * 2048, g4 = (wc * 4 + fq) * 4;
            f32x4 ks[2][2];
#pragma unroll
            for (int bj = 0; bj < 2; ++bj) { ks[bj][0] = (f32x4){0.f, 0.f, 0.f, 0.f}; ks[bj][1] = (f32x4){0.f, 0.f, 0.f, 0.f}; }
#pragma unroll
            for (int ai = 0; ai < 2; ++ai) {
                f32x4 cc[4], sn[4];
#pragma unroll
                for (int mm = 0; mm < 4; ++mm) { const int row = row0 + ai * HALF + mm * 16; cc[mm] = *(const f32x4*)(cosT + (size_t)row * 64 + g4); sn[mm] = *(const f32x4*)(sinT + (size_t)row * 64 + g4); }
                if (ai == 0) PG8_RS_READY(); else PG8_EPI_WAIT();
#pragma unroll
                for (int mm = 0; mm < 4; ++mm) { PG8_PIN(cc[mm]); PG8_PIN(sn[mm]); }
#pragma unroll
                for (int m2 = 0; m2 < 4; m2 += 2)
#pragma unroll
                    for (int bj = 0; bj < 2; ++bj) { u32x2 wa, wb;
#pragma unroll
                        for (int mq = 0; mq < 2; ++mq) { const int m = m2 + mq; const float r = rs[ai][m]; const f32x4 c4 = cc[m], s4 = sn[m];
                            const f32x4 x1 = acc[ai][bj][m][0] * r, x2 = acc[ai][bj][m][1] * r;
                            const f32x4 o1 = x1 * c4 - x2 * s4, o2 = x2 * c4 + x1 * s4;
                            u32x2 w; w.x = pg8_pk4_fp8(o1 * 8.0f); w.y = pg8_pk4_fp8(o2 * 8.0f); if (mq == 0) wa = w; else wb = w;
                            ks[bj][0] += o1; ks[bj][1] += o2; }
                        { const auto s0 = __builtin_amdgcn_permlane16_swap(wa.x, wb.x, false, false); wa.x = s0[0]; wb.x = s0[1]; }
                        { const auto s1 = __builtin_amdgcn_permlane16_swap(wa.y, wb.y, false, false); wa.y = s1[0]; wb.y = s1[1]; }
                        const int row = row0 + ai * HALF + (m2 + (fq & 1)) * 16;
                        *(u32x4*)((unsigned char*)dst + (size_t)row * 2048 + colh + bj * HALF + cw - 8 * (fq & 1)) = (u32x4){wa.x, wa.y, wb.x, wb.y}; } }
            if (reg == 1) { PG8_EPI_WAIT();
#pragma unroll
                for (int bj = 0; bj < 2; ++bj)
#pragma unroll
                    for (int n = 0; n < 2; ++n)
#pragma unroll
                        for (int e = 0; e < 4; ++e) { float v = ks[bj][n][e];
                            v += __shfl_xor(v, 1); v += __shfl_xor(v, 2); v += __shfl_xor(v, 4); v += __shfl_xor(v, 8);
                            if (fr == 0) atomicAdd(kacc + ((size_t)((colh >> 7) + bj) * 64 + u.pm) * 128 + cw + 4 * n + e, v); }
            }
        } else if (reg <= 4) {
            bf16_t* dst = QKVUG + (size_t)reg * ((size_t)16384 * 2048); const int colh = colt - reg * 2048;
            PG8_RS_READY();
            if (reg == 2) {
#pragma unroll
              for (int ai = 0; ai < 2; ++ai)
#pragma unroll
                for (int m2 = 0; m2 < 4; m2 += 2)
#pragma unroll
                    for (int bj = 0; bj < 2; ++bj) { u32x2 wa, wb;
                        wa.x = pg8_pk4_fp8(acc[ai][bj][m2][0] * (rs[ai][m2] * 8.0f)); wa.y = pg8_pk4_fp8(acc[ai][bj][m2][1] * (rs[ai][m2] * 8.0f));
                        wb.x = pg8_pk4_fp8(acc[ai][bj][m2 + 1][0] * (rs[ai][m2 + 1] * 8.0f)); wb.y = pg8_pk4_fp8(acc[ai][bj][m2 + 1][1] * (rs[ai][m2 + 1] * 8.0f));
                        { const auto s0 = __builtin_amdgcn_permlane16_swap(wa.x, wb.x, false, false); wa.x = s0[0]; wb.x = s0[1]; }
                        { const auto s1 = __builtin_amdgcn_permlane16_swap(wa.y, wb.y, false, false); wa.y = s1[0]; wb.y = s1[1]; }
                        const int row = row0 + ai * HALF + (m2 + (fq & 1)) * 16;
                        *(u32x4*)((unsigned char*)dst + (size_t)row * 2048 + colh + bj * HALF + cw - 8 * (fq & 1)) = (u32x4){wa.x, wa.y, wb.x, wb.y}; }
            } else {
#pragma unroll
              for (int ai = 0; ai < 2; ++ai)
#pragma unroll
                for (int m = 0; m < 4; ++m) { const int row = row0 + ai * HALF + m * 16; const float r = rs[ai][m];
#pragma unroll
                    for (int bj = 0; bj < 2; ++bj) { f32x4 v0 = acc[ai][bj][m][0] * r, v1 = acc[ai][bj][m][1] * r;
#pragma unroll
                        for (int e = 0; e < 4; ++e) { v0[e] = gelu_tanh(v0[e]); v1[e] = gelu_tanh(v1[e]); }
                        u32x4 w; w.x = cvt_pk_bf16(v0[0], v0[1]); w.y = cvt_pk_bf16(v0[2], v0[3]); w.z = cvt_pk_bf16(v1[0], v1[1]); w.w = cvt_pk_bf16(v1[2], v1[3]);
                        *(u32x4*)(dst + (size_t)row * 2048 + colh + bj * HALF + cw) = w; } }
            }
        } else {
            const int gcol = colt - 10240 + cw;
            f32x4 bv[2][2];
#pragma unroll
            for (int bj = 0; bj < 2; ++bj) { bv[bj][0] = *(const f32x4*)(bgate + gcol + bj * HALF); bv[bj][1] = *(const f32x4*)(bgate + gcol + bj * HALF + 4); }
            PG8_RS_READY();
#pragma unroll
            for (int bj = 0; bj < 2; ++bj) { PG8_PIN(bv[bj][0]); PG8_PIN(bv[bj][1]); }
            const int odd = fq & 1;
#pragma unroll
            for (int ai = 0; ai < 2; ++ai)
#pragma unroll
                for (int m = 0; m < 4; m += 2)
#pragma unroll
                    for (int bj = 0; bj < 2; ++bj) { u32x2 wa, wb;
#pragma unroll
                        for (int mm = 0; mm < 2; ++mm) { const float r = rs[ai][m + mm]; f32x4 v0 = acc[ai][bj][m + mm][0] * r + bv[bj][0], v1 = acc[ai][bj][m + mm][1] * r + bv[bj][1];
#pragma unroll
                            for (int e = 0; e < 4; ++e) { v0[e] = sigm(v0[e]); v1[e] = sigm(v1[e]); }
                            u32x2 w; w.x = pg8_pk4_fp8((v0 - 0.5f) * 256.0f); w.y = pg8_pk4_fp8((v1 - 0.5f) * 256.0f); if (mm == 0) wa = w; else wb = w; }
                        { const auto s0 = __builtin_amdgcn_permlane16_swap(wa.x, wb.x, false, false); wa.x = s0[0]; wb.x = s0[1]; }
                        { const auto s1 = __builtin_amdgcn_permlane16_swap(wa.y, wb.y, false, false); wa.y = s1[0]; wb.y = s1[1]; }
                        const int row = row0 + ai * HALF + (m + odd) * 16;
                        *(u32x4*)((unsigned char*)G + (size_t)row * 8192 + gcol - 8 * odd + bj * HALF) = (u32x4){wa.x, wa.y, wb.x, wb.y}; }
        }
    }
};
template <int SECOND> struct EpiMix {
    static constexpr bool PERM = true, AFTER_DRAIN = false;
    const bf16_t* G; bf16_t* MIX; bf16_t* TMP; float descale; float smix;
    __device__ __forceinline__ void operator()(const f32x4 (&acc)[2][2][4][2], const Unit& u, int wr, int wc, int fr, int fq) const {
        asm volatile("" : "+v"(fr), "+v"(fq));
        const int row0 = u.pm * BM + wr * 64 + fr, col0 = u.pn * BM + wc * 32 + 8 * fq;
#pragma unroll
        for (int ai = 0; ai < 2; ++ai) {
            u32x2 wout[4][2];
            u32x2 gv[4][2], pv[4][2];
#pragma unroll
            for (int m = 0; m < 4; ++m)
#pragma unroll
                for (int bj = 0; bj < 2; ++bj) { const size_t row = (size_t)(row0 + ai * HALF + m * 16); const int col = col0 + bj * HALF;
                    gv[m][bj] = *(const u32x2*)((const unsigned char*)G + row * 8192 + SECOND * 4096 + col);
                    if (SECOND) pv[m][bj] = *(const u32x2*)((const unsigned char*)TMP + row * 4096 + col); }
            PG8_EPI_WAIT();
#pragma unroll
            for (int m = 0; m < 4; ++m)
#pragma unroll
                for (int bj = 0; bj < 2; ++bj) { PG8_PIN(gv[m][bj]); if (SECOND) PG8_PIN(pv[m][bj]); }
#pragma unroll
            for (int m = 0; m < 4; ++m)
#pragma unroll
                for (int bj = 0; bj < 2; ++bj) { const size_t row = (size_t)(row0 + ai * HALF + m * 16); const int col = col0 + bj * HALF;
                    const u32x2 g = gv[m][bj];
                    f32x4 v0 = acc[ai][bj][m][0] * descale, v1 = acc[ai][bj][m][1] * descale;
                    { const f32x2 g0 = __builtin_amdgcn_cvt_pk_f32_fp8((int)g.x, false), g1 = __builtin_amdgcn_cvt_pk_f32_fp8((int)g.x, true), g2 = __builtin_amdgcn_cvt_pk_f32_fp8((int)g.y, false), g3 = __builtin_amdgcn_cvt_pk_f32_fp8((int)g.y, true);
                      constexpr float GI = 1.0f / 256.0f;
                      v0[0] *= g0.x * GI + 0.5f; v0[1] *= g0.y * GI + 0.5f; v0[2] *= g1.x * GI + 0.5f; v0[3] *= g1.y * GI + 0.5f; v1[0] *= g2.x * GI + 0.5f; v1[1] *= g2.y * GI + 0.5f; v1[2] *= g3.x * GI + 0.5f; v1[3] *= g3.y * GI + 0.5f; }
#if defined(PROBE_NO_ATTN)
                    if (!SECOND) { v0 = v0 * 0.f; v1 = v1 * 0.f; }
#endif
                    if (SECOND) { const u32x2 p = pv[m][bj];
                        const f32x2 p0 = __builtin_amdgcn_cvt_pk_f32_fp8((int)p.x, false), p1 = __builtin_amdgcn_cvt_pk_f32_fp8((int)p.x, true), p2 = __builtin_amdgcn_cvt_pk_f32_fp8((int)p.y, false), p3 = __builtin_amdgcn_cvt_pk_f32_fp8((int)p.y, true);
                        v0[0] += p0.x * (1.0f / 64.0f); v0[1] += p0.y * (1.0f / 64.0f); v0[2] += p1.x * (1.0f / 64.0f); v0[3] += p1.y * (1.0f / 64.0f);
                        v1[0] += p2.x * (1.0f / 64.0f); v1[1] += p2.y * (1.0f / 64.0f); v1[2] += p3.x * (1.0f / 64.0f); v1[3] += p3.y * (1.0f / 64.0f); }
                    (void)row; (void)col;
                    if (SECOND) { wout[m][bj].x = pg8_pk4_fp8(v0 * smix); wout[m][bj].y = pg8_pk4_fp8(v1 * smix); }
                    else { wout[m][bj].x = pg8_pk4_fp8(v0 * 64.0f); wout[m][bj].y = pg8_pk4_fp8(v1 * 64.0f); } }
#pragma unroll
            for (int m = 0; m < 4; m += 2)
#pragma unroll
                for (int bj = 0; bj < 2; ++bj) { u32x2 wa = wout[m][bj], wb = wout[m + 1][bj];
                    { const auto s0 = __builtin_amdgcn_permlane16_swap(wa.x, wb.x, false, false); wa.x = s0[0]; wb.x = s0[1]; }
                    { const auto s1 = __builtin_amdgcn_permlane16_swap(wa.y, wb.y, false, false); wa.y = s1[0]; wb.y = s1[1]; }
                    const size_t row = (size_t)(row0 + ai * HALF + (m + (fq & 1)) * 16); const int col = col0 + bj * HALF - 8 * (fq & 1);
                    *(u32x4*)((unsigned char*)(SECOND ? MIX : TMP) + row * 4096 + col) = (u32x4){wa.x, wa.y, wb.x, wb.y}; }
        }
    }
};
struct EpiWo {
    static constexpr bool PERM = true, AFTER_DRAIN = false;
    const float* x; float* x1; bf16_t* x1b; float* ss2; float descale;
    __device__ __forceinline__ void operator()(const f32x4 (&acc)[2][2][4][2], const Unit& u, int wr, int wc, int fr, int fq) const {
        asm volatile("" : "+v"(fr), "+v"(fq));
        const int row0 = u.pm * BM + wr * 64 + fr, col0 = u.pn * BM + wc * 32 + 8 * fq;
        const unsigned short* xb = (const unsigned short*)x;
        u32x4 xr[2][4][2];
#pragma unroll
        for (int ai = 0; ai < 2; ++ai)
#pragma unroll
            for (int mm = 0; mm < 4; ++mm)
#pragma unroll
                for (int bj = 0; bj < 2; ++bj) xr[ai][mm][bj] = *(const u32x4*)(xb + (size_t)(row0 + ai * HALF + mm * 16) * 4096 + col0 + bj * HALF);
        PG8_EPI_WAIT();
#pragma unroll
        for (int ai = 0; ai < 2; ++ai)
#pragma unroll
            for (int mm = 0; mm < 4; ++mm)
#pragma unroll
                for (int bj = 0; bj < 2; ++bj) PG8_PIN(xr[ai][mm][bj]);
#pragma unroll
        for (int ai = 0; ai < 2; ++ai) {
#pragma unroll
                for (int mm = 0; mm < 4; ++mm) { const int m = mm; const int row = row0 + ai * HALF + m * 16; float sq = 0.f;
#pragma unroll
                    for (int bj = 0; bj < 2; ++bj) { const size_t o = (size_t)row * 4096 + col0 + bj * HALF; const u32x4 xw = xr[ai][mm][bj];
                        const f32x4 xa = {__uint_as_float(xw.x << 16), __uint_as_float(xw.x & 0xffff0000u), __uint_as_float(xw.y << 16), __uint_as_float(xw.y & 0xffff0000u)};
                        const f32x4 xc = {__uint_as_float(xw.z << 16), __uint_as_float(xw.z & 0xffff0000u), __uint_as_float(xw.w << 16), __uint_as_float(xw.w & 0xffff0000u)};
                        const f32x4 v0 = xa + acc[ai][bj][m][0] * descale, v1 = xc + acc[ai][bj][m][1] * descale;
                        u32x4 w; w.x = cvt_pk_bf16(v0[0], v0[1]); w.y = cvt_pk_bf16(v0[2], v0[3]); w.z = cvt_pk_bf16(v1[0], v1[1]); w.w = cvt_pk_bf16(v1[2], v1[3]);
                        *(u32x4*)(x1b + o) = w;
                        sq += (v0[0] * v0[0] + v0[1] * v0[1]) + (v0[2] * v0[2] + v0[3] * v0[3]) + (v1[0] * v1[0] + v1[1] * v1[1]) + (v1[2] * v1[2] + v1[3] * v1[3]); }
                    sq += __shfl_xor(sq, 16); sq += __shfl_xor(sq, 32);
                    if (fq == 0) ss2[(size_t)row * 64 + u.pn * 4 + wc] = sq; }
            }
    }
};
struct EpiNull {
    static constexpr bool PERM = true, AFTER_DRAIN = false;
    __device__ __forceinline__ void operator()(const f32x4 (&acc)[2][2][4][2], const Unit& u, int wr, int wc, int fr, int fq) const {
#pragma unroll
        for (int ai = 0; ai < 2; ++ai)
#pragma unroll
            for (int bj = 0; bj < 2; ++bj)
#pragma unroll
                for (int m = 0; m < 4; ++m) { asm volatile("" :: "v"(acc[ai][bj][m][0]), "v"(acc[ai][bj][m][1])); } }
};
struct EpiS {
    static constexpr bool PERM = true, AFTER_DRAIN = false;
    float* S;
    __device__ __forceinline__ void operator()(const f32x4 (&acc)[2][2][4][2], const Unit& u, int wr, int wc, int fr, int fq) const {
        asm volatile("" : "+v"(fr), "+v"(fq));
        const int row0 = u.pm * BM + wr * 64 + fr, col0 = u.pn * BM + wc * 32 + 8 * fq;
#pragma unroll
        for (int ai = 0; ai < 2; ++ai)
#pragma unroll
            for (int m = 0; m < 4; ++m) { const int row = row0 + ai * HALF + m * 16;
#pragma unroll
                for (int bj = 0; bj < 2; ++bj) {
                    typedef _Float16 h2_t __attribute__((ext_vector_type(2)));
                    const f32x4 a0 = acc[ai][bj][m][0], a1 = acc[ai][bj][m][1];
                    u32x4 w; w.x = __builtin_bit_cast(unsigned, __builtin_amdgcn_cvt_pkrtz(a0[0], a0[1])); w.y = __builtin_bit_cast(unsigned, __builtin_amdgcn_cvt_pkrtz(a0[2], a0[3]));
                    w.z = __builtin_bit_cast(unsigned, __builtin_amdgcn_cvt_pkrtz(a1[0], a1[1])); w.w = __builtin_bit_cast(unsigned, __builtin_amdgcn_cvt_pkrtz(a1[2], a1[3]));
                    *(u32x4*)((unsigned short*)S + (size_t)row * 2048 + col0 + bj * HALF) = w; } }
    }
};
typedef int i32x8 __attribute__((ext_vector_type(8)));
typedef int i32x4 __attribute__((ext_vector_type(4)));
__device__ __forceinline__ i32x8 pg8_cat(bf16x8 lo, bf16x8 hi) { const i32x4 a = __builtin_bit_cast(i32x4, lo), b = __builtin_bit_cast(i32x4, hi); return __builtin_shufflevector(a, b, 0, 1, 2, 3, 4, 5, 6, 7); }
template <class Epi, class Sched, bool ALIGN_EPI = false, bool SP2 = false, bool F8 = false>
__device__ __forceinline__ void gemm_phase(PG8_LAS unsigned char* lds, const Gemm g, const Sched& S, const Epi& E) {
    const int tid = threadIdx.x, wid = __builtin_amdgcn_readfirstlane(tid >> 6), lane = tid & 63, wr = wid >> 2, wc = wid & 3, fr = lane & 15, fq = lane >> 4;
    constexpr int ESZ = F8 ? 1 : 2;
    const int K = g.K, nt = (K * ESZ) / 128;
    unsigned voffA[2], voffB[2];
#pragma unroll
    for (int i = 0; i < 2; ++i) { int R, C; stage_rc(tid * 16 + i * 8192, R, C); const int Rb = Epi::PERM ? ((R & ~31) + perm32(R & 31)) : R;
        voffA[i] = (unsigned)(R * K * ESZ + C * 2); voffB[i] = (unsigned)(Rb * K * ESZ + C * 2); }
    const size_t kstep = (size_t)(BK * 2);
    const size_t hstep = (size_t)HALF * K * ESZ;
    const size_t tstep = 2 * hstep;
    const unsigned ldsw = (unsigned)wid * 1024u;
    const int aoff0 = lds_byte(wr * 64 + fr, fq * 8), aoff1 = aoff0 + 1024;
    const int boff0 = lds_byte(wc * 32 + fr, fq * 8), boff1 = boff0 + 1024;
#define PG8_SA(b, h) (((b) * 2 + (h)) * HTB)
#define PG8_SB(b, h) ((4 + (b) * 2 + (h)) * HTB)
#define PG8_STAGE(bufoff, gbase, voff) do { _Pragma("unroll") for (int _i = 0; _i < 2; ++_i) \
        __builtin_amdgcn_global_load_lds((const unsigned*)((const char*)(gbase) + (voff)[_i]), (PG8_LAS unsigned*)(lds + (bufoff) + ldsw + _i * 8192), 16, 0, 0); } while (0)
#define PG8_LDA(dst, b, h) do { if constexpr (F8) { _Pragma("unroll") for (int m = 0; m < 4; ++m) dst##8[m] = pg8_cat(*(const PG8_LAS bf16x8*)(lds + PG8_SA(b, h) + aoff0 + m * 2048), *(const PG8_LAS bf16x8*)(lds + PG8_SA(b, h) + aoff1 + m * 2048)); }     \
    else { _Pragma("unroll") for (int m = 0; m < 4; ++m) _Pragma("unroll") for (int k = 0; k < 2; ++k) dst[m][k] = *(const PG8_LAS bf16x8*)(lds + PG8_SA(b, h) + (k ? aoff1 : aoff0) + m * 2048); } } while (0)
#define PG8_LDB(dst, b, h) do { if constexpr (F8) { _Pragma("unroll") for (int n = 0; n < 2; ++n) dst##8[n] = pg8_cat(*(const PG8_LAS bf16x8*)(lds + PG8_SB(b, h) + boff0 + n * 2048), *(const PG8_LAS bf16x8*)(lds + PG8_SB(b, h) + boff1 + n * 2048)); } \
    else { _Pragma("unroll") for (int n = 0; n < 2; ++n) _Pragma("unroll") for (int k = 0; k < 2; ++k) dst[n][k] = *(const PG8_LAS bf16x8*)(lds + PG8_SB(b, h) + (k ? boff1 : boff0) + n * 2048); } } while (0)
#define PG8_MMA(ai, bj, At, Bt) do { __builtin_amdgcn_s_setprio(1); _Pragma("unroll") for (int m = 0; m < 4; ++m) _Pragma("unroll") for (int n = 0; n < 2; ++n) { \
        if constexpr (F8) asm volatile("v_mfma_scale_f32_16x16x128_f8f6f4 %0, %1, %2, %0, %3, %3 op_sel_hi:[0,0,0]" : "+v"(acc[ai][bj][m][n]) : "v"(Bt##8[n]), "v"(At##8[m]), "v"(mxs));   \
        else { _Pragma("unroll") for (int k = 0; k < 2; ++k) acc[ai][bj][m][n] = __builtin_amdgcn_mfma_f32_16x16x32_bf16(Bt[n][k], At[m][k], acc[ai][bj][m][n], 0, 0, 0); } } __builtin_amdgcn_s_setprio(0); } while (0)
#define PG8_WAIT_V(n) asm volatile("s_waitcnt vmcnt(" #n ")" ::: "memory")
#define PG8_WAIT_L(n) asm volatile("s_waitcnt lgkmcnt(" #n ")" ::: "memory")
#define PG8_BAR __builtin_amdgcn_s_barrier()
#define PG8_SCHED __builtin_amdgcn_sched_barrier(0)
    Unit cur, nxt; int ui = 0;
    if (!S.next(0, cur)) return;
    f32x4 acc[2][2][4][2];
#pragma unroll
    for (int a = 0; a < 2; ++a)
#pragma unroll
        for (int b = 0; b < 2; ++b)
#pragma unroll
            for (int m = 0; m < 4; ++m)
#pragma unroll
                for (int n = 0; n < 2; ++n) acc[a][b][m][n] = (f32x4){0.f, 0.f, 0.f, 0.f};
    int mxs = 0x7f7f7f7f; asm volatile("" : "+v"(mxs));
    bf16x8 At[4][2], B0[2][2], B1[2][2];
    i32x8 At8[4], B08[2], B18[2];
    const char* cA = (const char*)g.A + (size_t)cur.pm * tstep; const char* cB = (const char*)g.Bt + (size_t)cur.pn * tstep;
    S.a_ready(cur);
    if constexpr (SP2) {
        PG8_STAGE(PG8_SB(0, 0), cB, voffB); PG8_STAGE(PG8_SB(0, 1), cB + hstep, voffB); PG8_STAGE(PG8_SA(0, 0), cA, voffA); PG8_STAGE(PG8_SA(0, 1), cA + hstep, voffA);
        if (wr == 1) PG8_BAR;
        PG8_WAIT_V(2); PG8_BAR;
        PG8_STAGE(PG8_SB(1, 0), cB + kstep, voffB); PG8_STAGE(PG8_SA(1, 0), cA + kstep, voffA); PG8_STAGE(PG8_SB(1, 1), cB + hstep + kstep, voffB);
        PG8_WAIT_V(6); PG8_BAR;
    } else {
        PG8_STAGE(PG8_SB(0, 0), cB, voffB); PG8_STAGE(PG8_SA(0, 0), cA, voffA); PG8_STAGE(PG8_SB(0, 1), cB + hstep, voffB); PG8_STAGE(PG8_SA(0, 1), cA + hstep, voffA);
        if (wr == 1) PG8_BAR;
        PG8_WAIT_V(4); PG8_BAR;
        PG8_STAGE(PG8_SB(1, 0), cB + kstep, voffB); PG8_STAGE(PG8_SA(1, 0), cA + kstep, voffA); PG8_STAGE(PG8_SB(1, 1), cB + hstep + kstep, voffB);
        PG8_WAIT_V(6); PG8_BAR;
    }
    for (;;) {
        const bool has_next = S.next(ui + 1, nxt);
        const char* nA = has_next ? (const char*)g.A + (size_t)nxt.pm * tstep : cA; const char* nB = has_next ? (const char*)g.Bt + (size_t)nxt.pn * tstep : cB;
        for (int t = 0; t < nt; t += 2) {
            const bool last = (t == nt - 2);
            const char* a1 = cA + (size_t)(t + 1) * kstep;
            const char* a2 = last ? nA : cA + (size_t)(t + 2) * kstep; const char* b2 = last ? nB : cB + (size_t)(t + 2) * kstep;
            const char* a3 = a2 + kstep; const char* b3 = b2 + kstep;
            if (last && has_next) S.a_ready(nxt);
            if constexpr (SP2) {
            PG8_LDB(B0, 0, 0); PG8_LDB(B1, 0, 1); PG8_SCHED; PG8_LDA(At, 0, 0); PG8_STAGE(PG8_SA(1, 1), a1 + hstep, voffA);
            PG8_WAIT_V(8); PG8_WAIT_L(0); PG8_BAR; PG8_MMA(0, 0, At, B0); PG8_MMA(0, 1, At, B1); PG8_BAR; PG8_SCHED;
            PG8_LDA(At, 0, 1); PG8_STAGE(PG8_SB(0, 0), b2, voffB); PG8_STAGE(PG8_SB(0, 1), b2 + hstep, voffB); PG8_STAGE(PG8_SA(0, 0), a2, voffA);
            PG8_WAIT_V(8); PG8_WAIT_L(0); PG8_BAR; PG8_MMA(1, 0, At, B0); PG8_MMA(1, 1, At, B1); PG8_BAR; PG8_SCHED;
            PG8_LDB(B0, 1, 0); PG8_LDB(B1, 1, 1); PG8_SCHED; PG8_LDA(At, 1, 0); PG8_STAGE(PG8_SA(0, 1), a2 + hstep, voffA);
            PG8_WAIT_V(8); PG8_WAIT_L(0); PG8_BAR; PG8_MMA(0, 0, At, B0); PG8_MMA(0, 1, At, B1); PG8_BAR; PG8_SCHED;
            PG8_LDA(At, 1, 1); PG8_STAGE(PG8_SB(1, 0), b3, voffB); PG8_STAGE(PG8_SB(1, 1), b3 + hstep, voffB); PG8_STAGE(PG8_SA(1, 0), a3, voffA);
            PG8_WAIT_V(8); PG8_WAIT_L(0); PG8_BAR; PG8_MMA(1, 0, At, B0); PG8_MMA(1, 1, At, B1); PG8_BAR; PG8_SCHED;
            } else {
            PG8_LDB(B0, 0, 0); PG8_SCHED; PG8_LDA(At, 0, 0); PG8_STAGE(PG8_SA(1, 1), a1 + hstep, voffA);
            PG8_WAIT_L(8); PG8_BAR; PG8_WAIT_L(0); PG8_MMA(0, 0, At, B0); PG8_BAR; PG8_SCHED;
            PG8_LDB(B1, 0, 1); PG8_STAGE(PG8_SB(0, 0), b2, voffB);
            PG8_BAR; PG8_WAIT_L(0); PG8_MMA(0, 1, At, B1); PG8_BAR;
            PG8_LDA(At, 0, 1); PG8_STAGE(PG8_SA(0, 0), a2, voffA);
            PG8_BAR; PG8_WAIT_L(0); PG8_MMA(1, 0, At, B0); PG8_BAR; PG8_SCHED;
            PG8_STAGE(PG8_SB(0, 1), b2 + hstep, voffB);
            PG8_WAIT_V(6); PG8_BAR; PG8_MMA(1, 1, At, B1); PG8_BAR;
            PG8_LDB(B0, 1, 0); PG8_SCHED; PG8_LDA(At, 1, 0); PG8_STAGE(PG8_SA(0, 1), a2 + hstep, voffA);
            PG8_WAIT_L(8); PG8_BAR; PG8_WAIT_L(0); PG8_MMA(0, 0, At, B0); PG8_BAR; PG8_SCHED;
            PG8_LDB(B1, 1, 1); PG8_STAGE(PG8_SB(1, 0), b3, voffB);
            PG8_BAR; PG8_WAIT_L(0); PG8_MMA(0, 1, At, B1); PG8_BAR;
            PG8_LDA(At, 1, 1); PG8_STAGE(PG8_SA(1, 0), a3, voffA);
            PG8_BAR; PG8_WAIT_L(0); PG8_MMA(1, 0, At, B0); PG8_BAR; PG8_SCHED;
            PG8_STAGE(PG8_SB(1, 1), b3 + hstep, voffB);
            PG8_WAIT_V(6); PG8_BAR; PG8_MMA(1, 1, At, B1); PG8_BAR;
            }
        }
        if constexpr (ALIGN_EPI) { if (wr == 0) PG8_BAR; }
        if constexpr (!Epi::AFTER_DRAIN) { E(acc, cur, wr, wc, fr, fq); S.done(cur);
#if defined(PROBE_EPI_DRAIN)
            PG8_WAIT_V(0);
#endif
        }
        if (!has_next) break;
#pragma unroll
        for (int a = 0; a < 2; ++a)
#pragma unroll
            for (int b = 0; b < 2; ++b)
#pragma unroll
                for (int m = 0; m < 4; ++m)
#pragma unroll
                    for (int n = 0; n < 2; ++n) acc[a][b][m][n] = (f32x4){0.f, 0.f, 0.f, 0.f};
        cur = nxt; cA = nA; cB = nB; ++ui;
        if constexpr (ALIGN_EPI) { if (wr == 1) PG8_BAR; }
    }
    PG8_WAIT_V(0);
    if constexpr (!ALIGN_EPI) { if (wr == 0) PG8_BAR; }
    PG8_BAR;
    if constexpr (Epi::AFTER_DRAIN) { E.fused(acc, cur, wr, wc, fr, fq, lds, wid, lane); S.done(cur); }
#undef PG8_SA
#undef PG8_SB
#undef PG8_STAGE
#undef PG8_LDA
#undef PG8_LDB
#undef PG8_MMA
#undef PG8_WAIT_V
#undef PG8_WAIT_L
#undef PG8_BAR
#undef PG8_SCHED
}
}
#define LAS __attribute__((address_space(3)))
#define XB_TMO      128
#define XB_XCNT(j)  (256  + 64 * (j))
#define XB_XSUB(j)  (1280 + 64 * (j))
#define XB_XGEN(j)  (2304 + 64 * (j))
#define XB_TOP      3328
#define XB_TOPGEN   3392
#define XCD_BAR_WORDS 3456
#define XB_SPIN_CAP (1u << 24)

__device__ __forceinline__ unsigned xb_ld(unsigned* p)              { return __hip_atomic_load(p, __ATOMIC_RELAXED, __HIP_MEMORY_SCOPE_AGENT); }
__device__ __forceinline__ unsigned xb_add(unsigned* p, unsigned v) { return __hip_atomic_fetch_add(p, v, __ATOMIC_RELAXED, __HIP_MEMORY_SCOPE_AGENT); }
__device__ __forceinline__ unsigned xb_xcc_id() { return (unsigned)__builtin_amdgcn_s_getreg((3 << 11) | 20) & 0xFu; }
#define XB_SPIN(cond, bar) do { unsigned _sp = 0; while (cond) { __builtin_amdgcn_s_sleep(1); \
    if ((++_sp & 255u) == 0u) { if (xb_ld(&(bar)[XB_TMO])) break; if (_sp > XB_SPIN_CAP) { atomicAdd(&(bar)[XB_TMO], 1u); break; } } } } while (0)

struct XcdBarrier {
    unsigned* bar; unsigned x;
    volatile LAS unsigned* st;
};

__device__ __forceinline__ XcdBarrier xcd_barrier_post(unsigned* bar, volatile LAS unsigned* st) {
    XcdBarrier b; b.bar = bar; b.x = xb_xcc_id(); b.st = st;
    if (threadIdx.x == 0) (void)xb_add(&bar[XB_XCNT(b.x)], 1u);
    return b;
}
__device__ __forceinline__ void xcd_barrier_complete(unsigned* bar, unsigned x, unsigned& nloc, unsigned& nx) {
    const unsigned G = gridDim.x * gridDim.y * gridDim.z;
    unsigned sum, cnt, mine, sp = 0u;
    for (;;) {
        sum = 0u; cnt = 0u; mine = 0u;
#pragma unroll
        for (unsigned j = 0; j < 16; ++j) { const unsigned c = xb_ld(&bar[XB_XCNT(j)]); sum += c; cnt += (c > 0u) ? 1u : 0u; mine = (j == x) ? c : mine; }
        if (sum == G) break;
        __builtin_amdgcn_s_sleep(1);
        if ((++sp & 255u) == 0u) { if (xb_ld(&bar[XB_TMO])) break; if (sp > XB_SPIN_CAP) { atomicAdd(&bar[XB_TMO], 1u); break; } }
    }
    nloc = mine > 0u ? mine : 1u; nx = cnt > 0u ? cnt : 1u;
}

__device__ __forceinline__ void xcd_barrier(const XcdBarrier& b) {
    asm volatile("s_waitcnt vmcnt(0)" ::: "memory");
    __syncthreads();
    if (threadIdx.x == 0) {
        unsigned* bar = b.bar;
        __builtin_amdgcn_s_waitcnt(0);
        unsigned nloc = b.st[0], nx = b.st[1];
        if (nloc == 0u) { xcd_barrier_complete(bar, b.x, nloc, nx); b.st[0] = nloc; b.st[1] = nx; }
        const unsigned old = xb_add(&bar[XB_XSUB(b.x)], 1u);
        const unsigned gen = old / nloc;
        if (old + 1u == (gen + 1u) * nloc) {
            __builtin_amdgcn_fence(__ATOMIC_RELEASE, "agent");
            asm volatile("s_waitcnt vmcnt(0)" ::: "memory");
            const unsigned og = xb_add(&bar[XB_TOP], 1u);
            const unsigned tg = og / nx;
            if (og + 1u == (tg + 1u) * nx) xb_add(&bar[XB_TOPGEN], 1u);
            else XB_SPIN(xb_ld(&bar[XB_TOPGEN]) == tg, bar);
            __builtin_amdgcn_fence(__ATOMIC_ACQUIRE, "agent");
            xb_add(&bar[XB_XGEN(b.x)], 1u);
            asm volatile("s_waitcnt vmcnt(0)" ::: "memory");
        } else {
            XB_SPIN(xb_ld(&bar[XB_XGEN(b.x)]) == gen, bar);
            __builtin_amdgcn_fence(__ATOMIC_ACQUIRE, "agent");
            asm volatile("s_waitcnt vmcnt(0)" ::: "memory");
        }
    }
    __syncthreads();
}
#ifndef PROBE_DUP
#define PROBE_DUP -1
#endif
#ifndef PROBE_PMODE
#define PROBE_PMODE 0
#endif

constexpr int T = 16384, D = 4096, AW = 2048, NH = 16, HD = 128, NBLK = 64, BLK = 256, N1 = 18432, GWD = 8192;
constexpr int NWAVES = 8;
constexpr float EPS = 1e-6f;
#ifndef N_LAUNCH
#define N_LAUNCH 1
#endif
constexpr int NPHASE = 9;

constexpr size_t MiB = 1u << 20;
constexpr size_t WS_CTL = 0, CTL_ZERO_BYTES = 1 * MiB;
constexpr int CW_BAR = 4096;
constexpr size_t CB_CNT = 160 * 1024;
constexpr size_t CB_KACC = 256 * 1024;
static_assert((CW_BAR + 9 * 3456) * 4 <= (int)CB_CNT && CB_KACC + 512 * 1024 <= CTL_ZERO_BYTES, "ctl map");
constexpr size_t WS_SS1 = 1 * MiB;
constexpr size_t WS_SS2 = 1108 * MiB;
constexpr size_t WS_COS = 2 * MiB, WS_SIN = 6 * MiB;
constexpr size_t WS_LIST = 10 * MiB;
constexpr size_t WS_ML = 44 * MiB;
constexpr size_t WS_WAP = 52 * MiB, WS_WSP = 68 * MiB, WS_WO = 84 * MiB, WS_W2 = 116 * MiB;
constexpr size_t WS_XB = 132 * MiB, WS_XB8 = 260 * MiB;
#ifndef ZUZV_FP8
#define ZUZV_FP8 1
#endif
constexpr size_t WS_W1Z = 980 * MiB, WS_W18 = 1012 * MiB;
constexpr size_t WS_AO8 = 980 * MiB;
constexpr size_t WS_OP = 132 * MiB;
constexpr size_t WS_Q = 404 * MiB, WS_K = 468 * MiB, WS_V = 532 * MiB, WS_U = 596 * MiB, WS_GV = 660 * MiB;
constexpr size_t WS_G = 724 * MiB;
constexpr size_t WS_AO = 980 * MiB, WS_SO = 1044 * MiB;
constexpr size_t WS_MIX = 132 * MiB, WS_X1B = 260 * MiB;
constexpr size_t WS_TU = 404 * MiB, WS_TV = 468 * MiB;
constexpr size_t WS_S = 724 * MiB;
constexpr size_t WS_XBF = 852 * MiB;
constexpr size_t WS_END = 1112 * MiB;
constexpr size_t LIST_HEAD_STRIDE = 516096;

constexpr int RING_BYTES = 131072;
constexpr int LDS_PRE = RING_BYTES;
constexpr int PEER_WAVE_LDS = 19456;
constexpr int LDS_MISC = 8 * PEER_WAVE_LDS;
constexpr int LDS_BYTES = LDS_MISC + 256;

#define GAS __attribute__((address_space(1)))
typedef unsigned short bf16;
typedef unsigned v4u __attribute__((ext_vector_type(4)));
typedef unsigned v2u __attribute__((ext_vector_type(2)));
typedef float f32x4 __attribute__((ext_vector_type(4)));
typedef float f32x2 __attribute__((ext_vector_type(2)));
typedef float f32x16 __attribute__((ext_vector_type(16)));
typedef short bf16x8 __attribute__((ext_vector_type(8)));
typedef short s16x4 __attribute__((ext_vector_type(4)));
#define LDS_WAIT() asm volatile("s_waitcnt lgkmcnt(0)" ::: "memory")
#define VM_WAIT() asm volatile("s_waitcnt vmcnt(0)" ::: "memory")
#define PIN(v) asm volatile("s_waitcnt vmcnt(0)" : "+v"(v) : : "memory")
typedef __bf16 bf16x2_t __attribute__((ext_vector_type(2)));
__device__ __forceinline__ unsigned cvtpk(float lo, float hi) { const f32x2 v = {lo, hi}; const bf16x2_t r = __builtin_convertvector(v, bf16x2_t); return __builtin_bit_cast(unsigned, r); }
constexpr float S_QKV = 8.0f;
__device__ __forceinline__ bf16x8 pack8(f32x4 a, f32x4 b);
__device__ __forceinline__ bf16x8 fp8x8_to_bf16(v2u w) {
    const f32x2 p0 = __builtin_amdgcn_cvt_pk_f32_fp8((int)w.x, false), p1 = __builtin_amdgcn_cvt_pk_f32_fp8((int)w.x, true), p2 = __builtin_amdgcn_cvt_pk_f32_fp8((int)w.y, false), p3 = __builtin_amdgcn_cvt_pk_f32_fp8((int)w.y, true);
    return pack8((f32x4){p0.x, p0.y, p1.x, p1.y}, (f32x4){p2.x, p2.y, p3.x, p3.y}); }
__device__ __forceinline__ bf16x8 pack8(f32x4 a, f32x4 b) { v4u w; w.x = cvtpk(a[0], a[1]); w.y = cvtpk(a[2], a[3]); w.z = cvtpk(b[0], b[1]); w.w = cvtpk(b[2], b[3]); return __builtin_bit_cast(bf16x8, w); }
__device__ __forceinline__ float clamp448(float x) { return fminf(fmaxf(x, -448.0f), 448.0f); }
__device__ __forceinline__ unsigned pk4_fp8(f32x4 a) { int w = 0; w = __builtin_amdgcn_cvt_pk_fp8_f32(clamp448(a[0]), clamp448(a[1]), w, false); w = __builtin_amdgcn_cvt_pk_fp8_f32(clamp448(a[2]), clamp448(a[3]), w, true); return (unsigned)w; }
#ifndef SGU_FP8
#define SGU_FP8 1
#endif
constexpr float S_SO = 16.0f, S_WSP = 128.0f;
constexpr float S_OP = 32.0f;
constexpr float S_X = 16.0f, S_W1 = 256.0f, S_AO = 64.0f, S_WAP = 128.0f, S_MIX = 16.0f, S_WO = 256.0f;
__device__ __forceinline__ float bflo(unsigned w) { return __uint_as_float(w << 16); }
__device__ __forceinline__ float bfhi(unsigned w) { return __uint_as_float(w & 0xffff0000u); }
__device__ __forceinline__ float wave_sum(float v) {
#pragma unroll
    for (int o = 1; o < 64; o <<= 1) v += __shfl_xor(v, o);
    return v;
}
#define DPP_I(v, ctrl) __builtin_amdgcn_update_dpp(0, (v), (ctrl), 0xF, 0xF, true)
__device__ __forceinline__ int imax(int a, int b) { return a > b ? a : b; }
__device__ __forceinline__ int row16_max_i(int v) { v = imax(v, DPP_I(v, 0xB1)); v = imax(v, DPP_I(v, 0x4E)); v = imax(v, DPP_I(v, 0x141)); v = imax(v, DPP_I(v, 0x140)); return v; }
__device__ __forceinline__ int half32_max_i(int v) { v = row16_max_i(v); const auto r = __builtin_amdgcn_permlane16_swap((unsigned)v, (unsigned)v, false, false); return imax((int)r[0], (int)r[1]); }
__device__ __forceinline__ int wave_max_fast_i(int v) { v = half32_max_i(v); const auto q = __builtin_amdgcn_permlane32_swap((unsigned)v, (unsigned)v, false, false); return imax((int)q[0], (int)q[1]); }
__device__ __forceinline__ float wave_sum_fast(float x) {
    int v = __float_as_int(x);
    x += __int_as_float(DPP_I(v, 0xB1)); v = __float_as_int(x); x += __int_as_float(DPP_I(v, 0x4E)); v = __float_as_int(x);
    x += __int_as_float(DPP_I(v, 0x141)); v = __float_as_int(x); x += __int_as_float(DPP_I(v, 0x140)); v = __float_as_int(x);
    const auto r = __builtin_amdgcn_permlane16_swap((unsigned)v, (unsigned)v, false, false); x = __uint_as_float(r[0]) + __uint_as_float(r[1]); v = __float_as_int(x);
    const auto q = __builtin_amdgcn_permlane32_swap((unsigned)v, (unsigned)v, false, false); return __uint_as_float(q[0]) + __uint_as_float(q[1]);
}
__device__ __forceinline__ int wave_max_i(int v) {
#pragma unroll
    for (int o = 1; o < 64; o <<= 1) { const int t = __shfl_xor(v, o); v = t > v ? t : v; }
    return v;
}
__device__ __forceinline__ unsigned offb(unsigned row, unsigned ch) { return 256u * row + 16u * (ch ^ (((row & 3u) << 2) | ((row >> 2) & 3u))); }
__device__ __forceinline__ bf16x8 tr_read2(unsigned a_lo, unsigned a_hi) {
    s16x4 lo, hi; asm volatile("ds_read_b64_tr_b16 %0, %2\n\tds_read_b64_tr_b16 %1, %3\n\ts_waitcnt lgkmcnt(0)" : "=&v"(lo), "=&v"(hi) : "v"(a_lo), "v"(a_hi) : "memory");
    return (bf16x8){lo[0], lo[1], lo[2], lo[3], hi[0], hi[1], hi[2], hi[3]}; }
__device__ __forceinline__ void tr_read4(unsigned a0, unsigned a1, unsigned a2, unsigned a3, bf16x8& o0, bf16x8& o1) {
    s16x4 r0, r1, r2, r3;
    asm volatile("ds_read_b64_tr_b16 %0, %4\n\tds_read_b64_tr_b16 %1, %5\n\tds_read_b64_tr_b16 %2, %6\n\tds_read_b64_tr_b16 %3, %7\n\ts_waitcnt lgkmcnt(0)"
                 : "=&v"(r0), "=&v"(r1), "=&v"(r2), "=&v"(r3) : "v"(a0), "v"(a1), "v"(a2), "v"(a3) : "memory");
    o0 = (bf16x8){r0[0], r0[1], r0[2], r0[3], r1[0], r1[1], r1[2], r1[3]}; o1 = (bf16x8){r2[0], r2[1], r2[2], r2[3], r3[0], r3[1], r3[2], r3[3]};
}
#define MFMA32(a, b, c) __builtin_amdgcn_mfma_f32_32x32x16_bf16((a), (b), (c), 0, 0, 0)

struct Params {
    const float *x, *norm_mix_g, *w_in, *w_attn_proj, *sgu_norm_g, *sgu_w, *sgu_b, *w_sgu_proj, *w_gate, *b_gate, *w_o, *norm_ffn_g, *peer_wq, *peer_subkeys, *peer_u, *peer_v, *norm_final_g;
    float* out; unsigned char* ws; int ph_lo, ph_hi, li, pad;
};

__device__ __forceinline__ void p0_transpose_item(const float* W, int K, int N, bf16* WT, int row_off, int permqk, const float* gk, LAS float* scr, int item, int lane) {
    const int nblk = N / 32, kb = item / nblk, nb = item % nblk, k0 = 64 * kb, n0 = 32 * nb;
    float wv_[32];
#pragma unroll
    for (int i = 0; i < 32; ++i) wv_[i] = W[(size_t)(k0 + 2 * i + (lane >> 5)) * N + n0 + (lane & 31)];
#pragma unroll
    for (int i = 0; i < 32; ++i) { const int kk = 2 * i + (lane >> 5); const float g = gk ? gk[k0 + kk] : 1.0f; scr[kk * 33 + (lane & 31)] = wv_[i] * g; }
    LDS_WAIT(); asm volatile("" ::: "memory");
    const int c = lane & 7;
    VM_WAIT();
#pragma unroll
    for (int j = 0; j < 4; ++j) { const int n = (lane >> 3) + 8 * j; const LAS float* s = scr + (8 * c) * 33 + n;
        v4u o; o.x = cvtpk(s[0 * 33], s[1 * 33]); o.y = cvtpk(s[2 * 33], s[3 * 33]); o.z = cvtpk(s[4 * 33], s[5 * 33]); o.w = cvtpk(s[6 * 33], s[7 * 33]);
        int nn = n0 + n;
        if (permqk && nn < 4096) { const int d = nn & 127, i = d & 63, hf = d >> 6; nn = (nn & ~127) + 8 * (i >> 2) + 4 * hf + (i & 3); }
        *(v4u*)(WT + (size_t)(row_off + nn) * K + k0 + 8 * c) = o; }
    LDS_WAIT(); asm volatile("" ::: "memory");
}
__device__ __forceinline__ void p0_transpose_item8(const float* W, int K, int N, unsigned char* WT, int row_off, int permqk, const float* gk, float scale, LAS float* scr, int item, int lane) {
    const int nblk = N / 32, kb = item / nblk, nb = item % nblk, k0 = 64 * kb, n0 = 32 * nb;
    float wv_[32];
#pragma unroll
    for (int i = 0; i < 32; ++i) wv_[i] = W[(size_t)(k0 + 2 * i + (lane >> 5)) * N + n0 + (lane & 31)];
#pragma unroll
    for (int i = 0; i < 32; ++i) { const int kk = 2 * i + (lane >> 5); const float g = gk ? gk[k0 + kk] : 1.0f; scr[kk * 33 + (lane & 31)] = wv_[i] * (g * scale); }
    LDS_WAIT(); asm volatile("" ::: "memory");
    const int c = lane & 3;
    VM_WAIT();
#pragma unroll
    for (int j = 0; j < 2; ++j) { const int n = (lane >> 2) + 16 * j; const LAS float* s = scr + (16 * c) * 33 + n;
        v4u o;
        o.x = pk4_fp8((f32x4){s[0 * 33], s[1 * 33], s[2 * 33], s[3 * 33]}); o.y = pk4_fp8((f32x4){s[4 * 33], s[5 * 33], s[6 * 33], s[7 * 33]});
        o.z = pk4_fp8((f32x4){s[8 * 33], s[9 * 33], s[10 * 33], s[11 * 33]}); o.w = pk4_fp8((f32x4){s[12 * 33], s[13 * 33], s[14 * 33], s[15 * 33]});
        int nn = n0 + n;
        if (permqk && nn < 4096) { const int d = nn & 127, i = d & 63, hf = d >> 6; nn = (nn & ~127) + 8 * (i >> 2) + 4 * hf + (i & 3); }
        *(v4u*)(WT + (size_t)(row_off + nn) * K + k0 + 16 * c) = o; }
    LDS_WAIT(); asm volatile("" ::: "memory");
}
__device__ __forceinline__ void p0_prologue(const Params& p, LAS unsigned char* lds, int tid, int lane, int wave) {
    unsigned char* ws = p.ws;
    const int gw = blockIdx.x * NWAVES + wave, NGW = gridDim.x * NWAVES;
    { bf16* XB = (bf16*)(ws + WS_XB); float* ss1 = (float*)(ws + WS_SS1);
      for (int row = gw; row < T; row += NGW) { const f32x4* xr = (const f32x4*)(p.x + (size_t)row * D); float s = 0.f;
          f32x4 xa[8], xb2[8];
#pragma unroll
          for (int j = 0; j < 8; ++j) { xa[j] = xr[128 * j + 2 * lane]; xb2[j] = xr[128 * j + 2 * lane + 1]; }
          VM_WAIT();
#pragma unroll
          for (int j = 0; j < 8; ++j) { PIN(xa[j]); PIN(xb2[j]); }
#pragma unroll
          for (int j = 0; j < 8; ++j) { const f32x4 a = xa[j], b = xb2[j];
              s += (a[0] * a[0] + a[1] * a[1]) + (a[2] * a[2] + a[3] * a[3]) + (b[0] * b[0] + b[1] * b[1]) + (b[2] * b[2] + b[3] * b[3]);
              v4u w; w.x = cvtpk(a[0], a[1]); w.y = cvtpk(a[2], a[3]); w.z = cvtpk(b[0], b[1]); w.w = cvtpk(b[2], b[3]);
              *(v4u*)(ws + WS_XBF + ((size_t)row * D + 512 * j + 8 * lane) * 2) = w;
              v2u w8; w8.x = pk4_fp8(a * S_X); w8.y = pk4_fp8(b * S_X); *(v2u*)(ws + WS_XB8 + (size_t)row * D + 512 * j + 8 * lane) = w8; }
          s = wave_sum(s); if (lane == 0) ss1[row] = s; } }
    { LAS float* scr = (LAS float*)(lds + wave * 16384);
      constexpr int I_IN = (D / 64) * (10240 / 32), I_GT = (D / 64) * (GWD / 32), I_AP = (AW / 64) * (D / 32), I_SP = I_AP, I_WO = (D / 64) * (D / 32);
      constexpr int NIT = I_IN + I_GT + I_AP + I_SP + I_WO;
      for (int it = gw; it < NIT; it += NGW) { int r = it;
          if (r < I_IN) { const int nb = r % (10240 / 32);
#if ZUZV_FP8
              (void)nb; p0_transpose_item8(p.w_in, D, 10240, ws + WS_W18, 0, 1, p.norm_mix_g, S_W1, scr, r, lane);
#else
              if (nb * 32 < 6144) p0_transpose_item8(p.w_in, D, 10240, ws + WS_W18, 0, 1, p.norm_mix_g, S_W1, scr, r, lane);
              else p0_transpose_item(p.w_in, D, 10240, (bf16*)(ws + WS_W1Z), -6144, 0, p.norm_mix_g, scr, r, lane);
#endif
              continue; } r -= I_IN;
          if (r < I_GT) { p0_transpose_item8(p.w_gate, D, GWD, ws + WS_W18, ZUZV_FP8 ? 10240 : 6144, 0, p.norm_mix_g, S_W1, scr, r, lane); continue; } r -= I_GT;
          if (r < I_AP) { p0_transpose_item8(p.w_attn_proj, AW, D, ws + WS_WAP, 0, 0, nullptr, S_WAP, scr, r, lane); continue; } r -= I_AP;
          if (r < I_SP) { if (SGU_FP8) p0_transpose_item8(p.w_sgu_proj, AW, D, ws + WS_WSP, 0, 0, nullptr, S_WSP, scr, r, lane); else p0_transpose_item(p.w_sgu_proj, AW, D, (bf16*)(ws + WS_WSP), 0, 0, nullptr, scr, r, lane); continue; } r -= I_SP;
          p0_transpose_item8(p.w_o, D, D, ws + WS_WO, 0, 0, nullptr, S_WO, scr, r, lane); } }
    { bf16* W2 = (bf16*)(ws + WS_W2);
      for (int it = gw; it < 16 * 128; it += NGW) { const int g16 = it >> 7, k0 = (it & 127) * 32, hh = lane >> 5, c = lane & 31;
          const float* wp = p.peer_wq + (size_t)(k0 + c) * 2048 + g16 * 128 + 8 * hh; bf16x8 Bf[8];
#pragma unroll
          for (int s = 0; s < 8; ++s) Bf[s] = pack8(*(const f32x4*)(wp + 16 * s), *(const f32x4*)(wp + 16 * s + 4));
          float gf = p.norm_ffn_g[k0 + c]; PIN(gf);
          for (int nt = 0; nt < 4; ++nt) { f32x16 acc = {};
              const float* sp = p.peer_subkeys + ((size_t)g16 * 128 + nt * 32 + c) * 128 + 8 * hh;
#pragma unroll
              for (int s = 0; s < 8; ++s) { f32x4 a0 = *(const f32x4*)(sp + 16 * s), a1 = *(const f32x4*)(sp + 16 * s + 4); PIN(a0); PIN(a1); acc = MFMA32(pack8(a0, a1), Bf[s], acc); }
              VM_WAIT();
#pragma unroll
              for (int r = 0; r < 16; ++r) { const int n = nt * 32 + (r & 3) + 8 * (r >> 2) + 4 * hh;
                  W2[(size_t)(g16 * 128 + n) * D + k0 + c] = (bf16)(cvtpk(acc[r] * gf, 0.f) & 0xffffu); } } } }
    { float* cosT = (float*)(ws + WS_COS); float* sinT = (float*)(ws + WS_SIN);
      for (int i = blockIdx.x * 512 + tid; i < T * 64; i += gridDim.x * 512) { const int t = i >> 6, f = i & 63;
          const float inv = exp2f(-(float)f * 0.20762050593046014f);
          const float ang = (float)t * inv;
          double rev = (double)ang * 0.15915494309189535; rev -= __builtin_rint(rev);
          const float fr = (float)rev;
          cosT[i] = __builtin_amdgcn_cosf(fr); sinT[i] = __builtin_amdgcn_sinf(fr); } }
}

__device__ __forceinline__ bool better(float a, int ja, float b, int jb) { return a > b || (a == b && ja < jb); }
__device__ __forceinline__ void top3_insert(float v, int j, float& v0, int& j0, float& v1, int& j1, float& v2, int& j2) {
    const bool b0 = better(v, j, v0, j0), b1 = better(v, j, v1, j1), b2 = better(v, j, v2, j2);
    v2 = b1 ? v1 : (b2 ? v : v2); j2 = b1 ? j1 : (b2 ? j : j2);
    v1 = b0 ? v0 : (b1 ? v : v1); j1 = b0 ? j0 : (b1 ? j : j1);
    v0 = b0 ? v : v0; j0 = b0 ? j : j0;
}
__device__ __forceinline__ size_t list_off(int h, int j) { return (size_t)h * LIST_HEAD_STRIDE + (size_t)256 * (63 * j - (j * (j - 1)) / 2); }
template <int NU>
__device__ __forceinline__ void moba_select_multi(const Params& p, int u0, int ustep, int lane, int wave) {
    unsigned char* ws = p.ws;
    const bf16* Q = (const bf16*)(ws + WS_Q); const float* kacc = (const float*)(ws + CB_KACC);
    unsigned* cnt = (unsigned*)(ws + CB_CNT); unsigned* list = (unsigned*)(ws + WS_LIST); f32x2* ML = (f32x2*)(ws + WS_ML);
    const int hh = lane >> 5, c = lane & 31;
    const float NINF = -__builtin_inff();
    float v0[NU], v1[NU], v2[NU]; int j0[NU], j1[NU], j2[NU]; bf16x8 qf[NU][8]; unsigned pos[NU][3];
#pragma unroll
    for (int i = 0; i < NU; ++i) { const int u = u0 + i * ustep; const int b = u & 63, h = u >> 6, t = b * BLK + wave * 32 + c;
        v0[i] = NINF; v1[i] = NINF; v2[i] = NINF; j0[i] = 1000; j1[i] = 1001; j2[i] = 1002;
        if (u < 1024 && b > 0) { const unsigned char* qp = (const unsigned char*)Q + (size_t)t * AW + h * HD + 8 * hh; v2u qraw[8];
#pragma unroll
            for (int s = 0; s < 8; ++s) qraw[s] = *(const v2u*)(qp + 16 * s);
#pragma unroll
            for (int s = 0; s < 8; ++s) qf[i][s] = fp8x8_to_bf16(qraw[s]); } }
#pragma unroll
    for (int i = 0; i < NU; ++i) { const int u = u0 + i * ustep; const int b = u & 63, h = u >> 6;
        if (u < 1024 && b > 0) {
#pragma unroll
            for (int jt = 0; jt < 2; ++jt) if (32 * jt < b) { f32x16 g = {};
                const float* kp = kacc + ((size_t)h * 64 + 32 * jt + c) * 128 + 8 * hh;
#pragma unroll
                for (int s = 0; s < 8; ++s) g = MFMA32(pack8(*(const f32x4*)(kp + 16 * s), *(const f32x4*)(kp + 16 * s + 4)), qf[i][s], g);
#pragma unroll
                for (int r = 0; r < 16; ++r) { const int j = 32 * jt + (r & 3) + 8 * (r >> 2) + 4 * hh; top3_insert(j < b ? g[r] : NINF, j, v0[i], j0[i], v1[i], j1[i], v2[i], j2[i]); } }
            const float pv0 = __shfl_xor(v0[i], 32), pv1 = __shfl_xor(v1[i], 32), pv2 = __shfl_xor(v2[i], 32);
            const int pj0 = __shfl_xor(j0[i], 32), pj1 = __shfl_xor(j1[i], 32), pj2 = __shfl_xor(j2[i], 32);
            top3_insert(pv0, pj0, v0[i], j0[i], v1[i], j1[i], v2[i], j2[i]); top3_insert(pv1, pj1, v0[i], j0[i], v1[i], j1[i], v2[i], j2[i]); top3_insert(pv2, pj2, v0[i], j0[i], v1[i], j1[i], v2[i], j2[i]);
        } }
    VM_WAIT();
#pragma unroll
    for (int i = 0; i < NU; ++i) { const int u = u0 + i * ustep; const int b = u & 63, h = u >> 6; const int nsel = b < 3 ? b : 3;
#pragma unroll
        for (int r = 0; r < 3; ++r) { const int j = r == 0 ? j0[i] : (r == 1 ? j1[i] : j2[i]); pos[i][r] = 0u; if (u < 1024 && hh == 0 && r < nsel) pos[i][r] = atomicAdd(cnt + h * 64 + j, 1u); } }
    VM_WAIT();
#pragma unroll
    for (int i = 0; i < NU; ++i)
#pragma unroll
        for (int r = 0; r < 3; ++r) PIN(pos[i][r]);
#pragma unroll
    for (int i = 0; i < NU; ++i) { const int u = u0 + i * ustep; const int b = u & 63, h = u >> 6, t = b * BLK + wave * 32 + c; const int nsel = b < 3 ? b : 3;
        if (u < 1024 && hh == 0) {
#pragma unroll
            for (int r = 0; r < 3; ++r) { const int j = r == 0 ? j0[i] : (r == 1 ? j1[i] : j2[i]);
                if (r < nsel) list[list_off(h, j) + pos[i][r]] = (unsigned)t | ((unsigned)r << 14);
                else ML[((size_t)r * T + t) * 16 + h] = (f32x2){NINF, 0.f}; } } }
}
__device__ __forceinline__ void sgu_unit(const Params& p, LAS unsigned char* lds, int cch, int g, int tid, int lane, int wave) {
    unsigned char* ws = p.ws;
    const bf16* GV = (const bf16*)(ws + WS_GV); const bf16* U = (const bf16*)(ws + WS_U); bf16* SO = (bf16*)(ws + WS_SO);
    LAS float* rsq = (LAS float*)(lds + 32768);
    f32x4 wpa[8], wpb[8];
    { const int tt0 = wave >> 1, hh0 = lane >> 5, c0 = lane & 31; const float* wrow0 = p.sgu_w + ((size_t)g * 128 + 32 * tt0 + c0) * 128 + 8 * hh0;
#pragma unroll
      for (int ks = 0; ks < 8; ++ks) if (ks < 2 * tt0 + 2) { wpa[ks] = *(const f32x4*)(wrow0 + 16 * ks); wpb[ks] = *(const f32x4*)(wrow0 + 16 * ks + 4); } }
    v4u gvw[4]; unsigned short uraw[2][16]; float bb[16], ngv[2];
#pragma unroll
    for (int i = 0; i < 4; ++i) { const int id = tid + 512 * i, row = id >> 4, ch = id & 15; gvw[i] = *(const v4u*)(GV + (size_t)(cch * 128 + row) * AW + g * 128 + ch * 8); }
    { const int tt0 = wave >> 1, dt00 = (wave & 1) * 2, hh0 = lane >> 5, c0 = lane & 31;
#pragma unroll
      for (int r = 0; r < 16; ++r) { const int tl = 32 * tt0 + (r & 3) + 8 * (r >> 2) + 4 * hh0; bb[r] = p.sgu_b[g * 128 + tl];
#pragma unroll
          for (int d2 = 0; d2 < 2; ++d2) uraw[d2][r] = *(const unsigned short*)(U + (size_t)(cch * 128 + tl) * AW + g * 128 + 32 * (dt00 + d2) + c0); }
#pragma unroll
      for (int d2 = 0; d2 < 2; ++d2) ngv[d2] = p.sgu_norm_g[g * 128 + 32 * (dt00 + d2) + c0]; }
    __syncthreads();
    VM_WAIT();
#pragma unroll
    for (int i = 0; i < 4; ++i) { const int id = tid + 512 * i, row = id >> 4, ch = id & 15;
        v4u w = gvw[i]; PIN(w);
        *(LAS v4u*)(lds + offb(row, ch)) = w;
        float s = bflo(w.x) * bflo(w.x) + bfhi(w.x) * bfhi(w.x) + bflo(w.y) * bflo(w.y) + bfhi(w.y) * bfhi(w.y)
                + bflo(w.z) * bflo(w.z) + bfhi(w.z) * bfhi(w.z) + bflo(w.w) * bflo(w.w) + bfhi(w.w) * bfhi(w.w);
        s += __shfl_xor(s, 1); s += __shfl_xor(s, 2); s += __shfl_xor(s, 4); s += __shfl_xor(s, 8);
        if (ch == 0) rsq[row] = rsqrtf(s * (1.0f / 128.0f) + EPS); }
    __syncthreads();
    const int tt = wave >> 1, dt0 = (wave & 1) * 2, hh = lane >> 5, c = lane & 31;
    const int blk = (lane >> 4) & 1, q4 = (lane & 15) >> 2, pp = lane & 3;
    f32x16 acc[2] = {};
    const float* wrow = p.sgu_w + ((size_t)g * 128 + 32 * tt + c) * 128 + 8 * hh;
    const unsigned lbase = (unsigned)(uintptr_t)lds;
    VM_WAIT();
#pragma unroll
    for (int ks = 0; ks < 8; ++ks) if (ks < 2 * tt + 2) {
        const int s0 = 16 * ks + 8 * hh, trow = 32 * tt + c;
        f32x4 wa = wpa[ks], wb = wpb[ks]; PIN(wa); PIN(wb);
        const f32x4 ra = *(const LAS f32x4*)(rsq + s0), rb = *(const LAS f32x4*)(rsq + s0 + 4);
#pragma unroll
        for (int e = 0; e < 4; ++e) { wa[e] = (s0 + e <= trow) ? wa[e] * ra[e] : 0.f; wb[e] = (s0 + 4 + e <= trow) ? wb[e] * rb[e] : 0.f; }
        const bf16x8 A = pack8(wa, wb);
#pragma unroll
        for (int d2 = 0; d2 < 2; ++d2) { const int dt = dt0 + d2;
            const bf16x8 B = tr_read2(lbase + offb(16 * ks + 8 * hh + q4, 4 * dt + 2 * blk + (pp >> 1)) + 8 * (pp & 1),
                                      lbase + offb(16 * ks + 8 * hh + 4 + q4, 4 * dt + 2 * blk + (pp >> 1)) + 8 * (pp & 1));
            acc[d2] = MFMA32(A, B, acc[d2]); }
    }
#pragma unroll
    for (int d2 = 0; d2 < 2; ++d2) { const int d = 32 * (dt0 + d2) + c; float ng = ngv[d2]; PIN(ng);
        float uu[16];
#pragma unroll
        for (int r = 0; r < 16; ++r) { unsigned ur = uraw[d2][r]; PIN(ur); PIN(bb[r]); uu[r] = __uint_as_float(ur << 16); }
#pragma unroll
        for (int r = 0; r < 16; ++r) { const int tl = 32 * tt + (r & 3) + 8 * (r >> 2) + 4 * hh;
            const size_t o = (size_t)(cch * 128 + tl) * AW + g * 128 + d;
#ifndef PROBE_WV
#define PROBE_WV 1.0f
#endif
#if SGU_FP8
            ((unsigned char*)SO)[o] = (unsigned char)(__builtin_amdgcn_cvt_pk_fp8_f32(clamp448(uu[r] * (PROBE_WV * acc[d2][r] * ng + bb[r]) * S_SO), 0.f, 0, false) & 0xff); } }
#else
            SO[o] = (bf16)(cvtpk(uu[r] * (PROBE_WV * acc[d2][r] * ng + bb[r]), 0.f) & 0xffffu); } }
#endif
}

__device__ __forceinline__ pg8::i32x8 cat8(v4u a, v4u b) { return (pg8::i32x8){(int)a.x, (int)a.y, (int)a.z, (int)a.w, (int)b.x, (int)b.y, (int)b.z, (int)b.w}; }
#define MFMA64(A, B, C) __builtin_amdgcn_mfma_scale_f32_32x32x64_f8f6f4((A), (B), (C), 0, 0, 0, 0x7f7f7f7f, 0, 0x7f7f7f7f)
__device__ __forceinline__ void attn_item(const Params& p, LAS unsigned char* lds, int h, int jblk, bool own, const unsigned* lst, int cnt, int ti, bool newkv, int tid, int lane, int wave) {
    unsigned char* ws = p.ws;
    const unsigned char* Q = ws + WS_Q; const unsigned char* Kg = ws + WS_K + (size_t)(jblk * BLK) * AW + h * HD; const unsigned char* Vg = ws + WS_V + (size_t)(jblk * BLK) * AW + h * HD;
    f32x2* ML = (f32x2*)(ws + WS_ML);
    asm volatile("" : "+v"(lane));
    const int hh = lane >> 5, c = lane & 31;
    constexpr unsigned VT0 = 32768u;
    if (newkv) {
        __syncthreads();
        v4u kr[4], vr[4];
        const int vg4 = 4 * (tid & 63), vch = tid >> 6;
#pragma unroll
        for (int i = 0; i < 4; ++i) { const int id = tid + 512 * i, row = id >> 3, ch = id & 7; kr[i] = *(const v4u*)(Kg + (size_t)row * AW + ch * 16); vr[i] = *(const v4u*)(Vg + (size_t)(vg4 + i) * AW + vch * 16); }
#pragma unroll
        for (int i = 0; i < 4; ++i) { const int id = tid + 512 * i, row = id >> 3, ch = id & 7; *(LAS v4u*)(lds + row * 128 + 16 * (ch ^ ((row >> 1) & 7))) = kr[i]; }
        { const int kk = vg4 & 31, pos = 64 * (vg4 >> 6) + 32 * ((kk >> 2) & 1) + 16 * ((vg4 >> 5) & 1) + 4 * (kk >> 3);
          LAS unsigned char* vt = lds + VT0 + (16 * vch) * 256 + (pos & 15);
#pragma unroll
          for (int q4 = 0; q4 < 4; ++q4) {
              const unsigned k0 = q4 == 0 ? vr[0].x : (q4 == 1 ? vr[0].y : (q4 == 2 ? vr[0].z : vr[0].w)), k1 = q4 == 0 ? vr[1].x : (q4 == 1 ? vr[1].y : (q4 == 2 ? vr[1].z : vr[1].w));
              const unsigned k2 = q4 == 0 ? vr[2].x : (q4 == 1 ? vr[2].y : (q4 == 2 ? vr[2].z : vr[2].w)), k3 = q4 == 0 ? vr[3].x : (q4 == 1 ? vr[3].y : (q4 == 2 ? vr[3].z : vr[3].w));
              const unsigned t0 = __builtin_amdgcn_perm(k1, k0, 0x05010400u), t1 = __builtin_amdgcn_perm(k1, k0, 0x07030602u), t2 = __builtin_amdgcn_perm(k3, k2, 0x05010400u), t3 = __builtin_amdgcn_perm(k3, k2, 0x07030602u);
              const unsigned d0 = __builtin_amdgcn_perm(t2, t0, 0x05040100u), d1 = __builtin_amdgcn_perm(t2, t0, 0x07060302u), d2 = __builtin_amdgcn_perm(t3, t1, 0x05040100u), d3 = __builtin_amdgcn_perm(t3, t1, 0x07060302u);
              const int b0 = 4 * q4;
              *(LAS unsigned*)(vt + (b0 + 0) * 256 + 16 * ((pos >> 4) ^ (b0 + 0))) = d0; *(LAS unsigned*)(vt + (b0 + 1) * 256 + 16 * ((pos >> 4) ^ (b0 + 1))) = d1;
              *(LAS unsigned*)(vt + (b0 + 2) * 256 + 16 * ((pos >> 4) ^ (b0 + 2))) = d2; *(LAS unsigned*)(vt + (b0 + 3) * 256 + 16 * ((pos >> 4) ^ (b0 + 3))) = d3; } } }
    int t, slot; bool valid;
    if (own) { t = jblk * BLK + wave * 32 + c; slot = 3; valid = true; }
    else { const int qi = ti * 256 + wave * 32 + c; valid = qi < cnt; const unsigned e = lst[valid ? qi : 0]; t = (int)(e & 16383u); slot = (int)(e >> 14); }
    const bool wactive = own || (ti * 256 + wave * 32 < cnt);
    pg8::i32x8 qf8[2];
    { const unsigned char* qp = Q + (size_t)t * AW + h * HD + 32 * hh;
#pragma unroll
      for (int cq = 0; cq < 2; ++cq) qf8[cq] = cat8(*(const v4u*)(qp + 64 * cq), *(const v4u*)(qp + 64 * cq + 16)); }
    if (newkv) __syncthreads();
    if (!wactive) return;
    const float NINF = -__builtin_inff();
    f32x16 sc[8];
#pragma unroll
    for (int kt = 0; kt < 8; ++kt) {
        sc[kt] = (f32x16){};
        if (!own || kt <= wave) { const int key = 32 * kt + c, sw = (key >> 1) & 7;
#pragma unroll
            for (int cq = 0; cq < 2; ++cq) { const int c0 = 4 * cq + 2 * hh;
                const pg8::i32x8 kf = cat8(*(const LAS v4u*)(lds + key * 128 + 16 * (c0 ^ sw)), *(const LAS v4u*)(lds + key * 128 + 16 * ((c0 + 1) ^ sw)));
                sc[kt] = MFMA64(kf, qf8[cq], sc[kt]); }
        }
    }
    if (own) {
#pragma unroll
        for (int kt = 0; kt < 8; ++kt) {
            if (kt == wave) {
#pragma unroll
                for (int r = 0; r < 16; ++r) { const int kl = (r & 3) + 8 * (r >> 2) + 4 * hh; if (kl > c) sc[kt][r] = NINF; }
            } else if (kt > wave) {
#pragma unroll
                for (int r = 0; r < 16; ++r) sc[kt][r] = NINF;
            }
        }
    }
    float mx = NINF;
#pragma unroll
    for (int kt = 0; kt < 8; ++kt)
#pragma unroll
        for (int r = 0; r < 16; ++r) mx = fmaxf(mx, sc[kt][r]);
    mx = fmaxf(mx, __shfl_xor(mx, 32));
    constexpr float C = 0.08838834764831845f * 1.4426950408889634f / (S_QKV * S_QKV);
    constexpr float S_P = 128.0f;
    const float mC = mx * C, mCs = mC - 7.0f; float ls = 0.f;
    pg8::i32x8 pf8[4];
#pragma unroll
    for (int kt = 0; kt < 8; ++kt) {
#pragma unroll
        for (int r = 0; r < 16; ++r) { const float e = __builtin_amdgcn_exp2f(sc[kt][r] * C - mCs); sc[kt][r] = e; ls += e; }
#pragma unroll
        for (int j = 0; j < 4; ++j) { int w = 0; w = __builtin_amdgcn_cvt_pk_fp8_f32(sc[kt][4 * j], sc[kt][4 * j + 1], w, false); w = __builtin_amdgcn_cvt_pk_fp8_f32(sc[kt][4 * j + 2], sc[kt][4 * j + 3], w, true); pf8[kt >> 1][4 * (kt & 1) + j] = w; }
    }
    ls += __shfl_xor(ls, 32);
    int l3 = lane; asm volatile("" : "+v"(l3), "+v"(ls));
    const int c3 = l3 & 31, hh3 = l3 >> 5;
    f32x16 o[4] = {};
#pragma unroll
    for (int pq = 0; pq < 4; ++pq) {
        if (!own || 2 * pq <= wave) {
#pragma unroll
            for (int dt = 0; dt < 4; ++dt) { const int d = 32 * dt + c3, c0 = 4 * pq + 2 * hh3, sw = c3 & 15;
                const pg8::i32x8 vf = cat8(*(const LAS v4u*)(lds + VT0 + d * 256 + 16 * (c0 ^ sw)), *(const LAS v4u*)(lds + VT0 + d * 256 + 16 * ((c0 + 1) ^ sw)));
                o[dt] = MFMA64(vf, pf8[pq], o[dt]); }
        }
    }
    VM_WAIT();
    { const float inv = S_OP / (ls * S_QKV); unsigned char* rowp = (unsigned char*)(ws + WS_OP) + ((((size_t)slot * T + t) * 16 + h) * 128) + (hh ? 16 : 0);
#pragma unroll
      for (int dt = 0; dt < 4; ++dt) { unsigned g0, g1, g2, g3;
          g0 = pk4_fp8((f32x4){o[dt][0], o[dt][1], o[dt][2], o[dt][3]} * inv); g1 = pk4_fp8((f32x4){o[dt][4], o[dt][5], o[dt][6], o[dt][7]} * inv);
          g2 = pk4_fp8((f32x4){o[dt][8], o[dt][9], o[dt][10], o[dt][11]} * inv); g3 = pk4_fp8((f32x4){o[dt][12], o[dt][13], o[dt][14], o[dt][15]} * inv);
          { const auto r = __builtin_amdgcn_permlane32_swap(g0, g1, false, false); g0 = r[0]; g1 = r[1]; }
          { const auto r = __builtin_amdgcn_permlane32_swap(g2, g3, false, false); g2 = r[0]; g3 = r[1]; }
          { const auto r = __builtin_amdgcn_permlane32_swap(g0, g2, false, false); g0 = r[0]; g2 = r[1]; }
          { const auto r = __builtin_amdgcn_permlane32_swap(g1, g3, false, false); g1 = r[0]; g3 = r[1]; }
          if (valid) *(v4u*)(rowp + 32 * dt) = (v4u){g0, g1, g2, g3}; }
      if (valid && hh == 0) ML[((size_t)slot * T + t) * 16 + h] = (f32x2){mC, ls * (1.0f / S_P)}; }
}
__device__ __forceinline__ void attn_phase(const Params& p, LAS unsigned char* lds, int tid, int lane, int wave) {
    unsigned char* ws = p.ws;
    const unsigned* cntg = (const unsigned*)(ws + CB_CNT); const unsigned* list = (const unsigned*)(ws + WS_LIST);
    LAS int* pre = (LAS int*)(lds + LDS_PRE); LAS int* wsum = (LAS int*)(lds + LDS_MISC) + 16;
    { const int a = (int)((cntg[2 * tid] + 255u) >> 8) + 1, b2 = (int)((cntg[2 * tid + 1] + 255u) >> 8) + 1, s = a + b2; int x = s;
#pragma unroll
      for (int o = 1; o < 64; o <<= 1) { const int y = __shfl_up(x, o); if (lane >= o) x += y; }
      if (lane == 63) wsum[wave] = x;
      __syncthreads();
      int woff = 0;
      for (int w = 0; w < wave; ++w) woff += wsum[w];
      const int ex = woff + x - s; pre[2 * tid] = ex; pre[2 * tid + 1] = ex + a;
      __syncthreads(); }
    int nitems = 0;
    for (int w = 0; w < NWAVES; ++w) nitems += wsum[w];
    const int i0 = (int)(((long long)nitems * (int)blockIdx.x) / (int)gridDim.x), i1 = (int)(((long long)nitems * ((int)blockIdx.x + 1)) / (int)gridDim.x);
    int cur = -1;
    for (int it = i0; it < i1; ++it) {
        int lo = 0, hi = 1023;
        while (lo < hi) { const int mid = (lo + hi + 1) >> 1; if (pre[mid] <= it) lo = mid; else hi = mid - 1; }
        const int h = lo >> 6, j = lo & 63, ti = it - pre[lo], cnt = (int)cntg[lo]; const bool newkv = lo != cur; cur = lo;
        if (ti == ((cnt + 255) >> 8)) attn_item(p, lds, h, j, true, nullptr, 0, 0, newkv, tid, lane, wave);
        else attn_item(p, lds, h, j, false, list + list_off(h, j), cnt, ti, newkv, tid, lane, wave);
    }
}
__device__ __forceinline__ void attn_combine(const Params& p, int lane, int wave) {
    unsigned char* ws = p.ws;
    const unsigned char* OP = ws + WS_OP; const f32x2* ML = (const f32x2*)(ws + WS_ML); unsigned char* AO8 = ws + WS_AO8;
    const int gw = blockIdx.x * NWAVES + wave, NGW = gridDim.x * NWAVES;
    for (int i0 = gw; i0 < T * 4; i0 += 4 * NGW) {
        f32x2 ml[4][4]; v2u ov4[4][4];
#pragma unroll
        for (int q = 0; q < 4; ++q) { const int i = i0 + q * NGW; if (i < T * 4) { const int t = i >> 2, h = (i & 3) * 4 + (lane >> 4), d0 = (lane & 15) * 8;
#pragma unroll
            for (int s = 0; s < 4; ++s) { ml[q][s] = ML[((size_t)s * T + t) * 16 + h]; ov4[q][s] = *(const v2u*)(OP + (((size_t)s * T + t) * 16 + h) * 128 + d0); } } }
        VM_WAIT();
#pragma unroll
        for (int q = 0; q < 4; ++q)
#pragma unroll
            for (int s = 0; s < 4; ++s) { PIN(ml[q][s]); PIN(ov4[q][s]); }
#pragma unroll
        for (int q = 0; q < 4; ++q) { const int i = i0 + q * NGW; if (i < T * 4) { const int t = i >> 2, h = (i & 3) * 4 + (lane >> 4), d0 = (lane & 15) * 8;
            float M = -__builtin_inff();
#pragma unroll
            for (int s = 0; s < 4; ++s) { if (ml[q][s].y > 0.f) M = fmaxf(M, ml[q][s].x); }
            float w[4], W = 0.f;
#pragma unroll
            for (int s = 0; s < 4; ++s) { w[s] = ml[q][s].y > 0.f ? ml[q][s].y * __builtin_amdgcn_exp2f(ml[q][s].x - M) : 0.f; W += w[s]; }
            const float iW = 1.0f / W; float acc[8] = {0.f, 0.f, 0.f, 0.f, 0.f, 0.f, 0.f, 0.f};
#pragma unroll
            for (int s = 0; s < 4; ++s) { const v2u v = ov4[q][s]; const float ww = w[s] * iW * (1.0f / S_OP);
                if (ww > 0.f) { const f32x2 p0 = __builtin_amdgcn_cvt_pk_f32_fp8((int)v.x, false), p1 = __builtin_amdgcn_cvt_pk_f32_fp8((int)v.x, true), p2 = __builtin_amdgcn_cvt_pk_f32_fp8((int)v.y, false), p3 = __builtin_amdgcn_cvt_pk_f32_fp8((int)v.y, true);
                                acc[0] += ww * p0.x; acc[1] += ww * p0.y; acc[2] += ww * p1.x; acc[3] += ww * p1.y; acc[4] += ww * p2.x; acc[5] += ww * p2.y; acc[6] += ww * p3.x; acc[7] += ww * p3.y; } }
            v2u o; o.x = pk4_fp8((f32x4){acc[0], acc[1], acc[2], acc[3]} * S_AO); o.y = pk4_fp8((f32x4){acc[4], acc[5], acc[6], acc[7]} * S_AO);
            *(v2u*)(AO8 + (size_t)t * AW + h * HD + d0) = o; } }
    }
}
constexpr float PEER_SU = 128.0f, PEER_SV = 4.0f;
constexpr int PEER_ROWB = 2048;
__device__ __forceinline__ float clamp6(float x) { return fminf(fmaxf(x, -6.0f), 6.0f); }
__device__ __forceinline__ void peer_pack_row_piece4(const float* src, const f32x4 (&g)[4][4], float scale, unsigned char* dst, int L) {
    unsigned w[8]; f32x4 v[4][4];
#pragma unroll
    for (int c = 0; c < 4; ++c)
#pragma unroll
        for (int j = 0; j < 4; ++j) v[c][j] = *(const f32x4*)(src + 1024 * c + 16 * L + 4 * j);
    VM_WAIT();
#pragma unroll
    for (int c = 0; c < 4; ++c) {
#pragma unroll
        for (int j = 0; j < 4; ++j) PIN(v[c][j]);
#pragma unroll
        for (int j = 0; j < 4; ++j)
#pragma unroll
            for (int e = 0; e < 4; ++e) v[c][j][e] = clamp6(v[c][j][e] * g[c][j][e] * scale);
#pragma unroll
        for (int d = 0; d < 2; ++d) { unsigned x = 0;
            x = __builtin_amdgcn_cvt_scalef32_pk_fp4_f32(x, v[c][2 * d][0], v[c][2 * d][1], 1.0f, 0); x = __builtin_amdgcn_cvt_scalef32_pk_fp4_f32(x, v[c][2 * d][2], v[c][2 * d][3], 1.0f, 1);
            x = __builtin_amdgcn_cvt_scalef32_pk_fp4_f32(x, v[c][2 * d + 1][0], v[c][2 * d + 1][1], 1.0f, 2); x = __builtin_amdgcn_cvt_scalef32_pk_fp4_f32(x, v[c][2 * d + 1][2], v[c][2 * d + 1][3], 1.0f, 3);
            w[2 * c + d] = x; }
    }
    *(v4u*)(dst + 16 * L) = (v4u){w[0], w[1], w[2], w[3]}; *(v4u*)(dst + 1024 + 16 * L) = (v4u){w[4], w[5], w[6], w[7]};
}
__device__ __forceinline__ void peer_tables(const Params& p, int tid) {
    unsigned char* ws = p.ws; unsigned char* TU = ws + WS_TU; unsigned char* TV = ws + WS_TV;
    const int L = tid & 63;
    f32x4 gu[4][4], g1[4][4];
#pragma unroll
    for (int c = 0; c < 4; ++c)
#pragma unroll
        for (int j = 0; j < 4; ++j) { gu[c][j] = *(const f32x4*)(p.norm_ffn_g + 1024 * c + 16 * L + 4 * j); g1[c][j] = (f32x4){1.f, 1.f, 1.f, 1.f}; }
    VM_WAIT();
#pragma unroll
    for (int c = 0; c < 4; ++c)
#pragma unroll
        for (int j = 0; j < 4; ++j) PIN(gu[c][j]);
    for (size_t i = (size_t)blockIdx.x * 512 + tid; i < (size_t)16384 * 64; i += (size_t)gridDim.x * 512) { const size_t e = i >> 6;
        peer_pack_row_piece4(p.peer_u + e * D, gu, PEER_SU, TU + e * PEER_ROWB, L);
        peer_pack_row_piece4(p.peer_v + e * D, g1, PEER_SV, TV + e * PEER_ROWB, L); }
}
#ifndef PROBE_SKIP_PEER
#define PROBE_SKIP_PEER 0
#endif
#ifndef PROBE_SP
#define PROBE_SP 1.0f
#endif
__device__ __forceinline__ int f2ord(float f) { const int b = __float_as_int(f); return b ^ ((b >> 31) & 0x7fffffff); }
__device__ __forceinline__ void peer_phase(const Params& p, LAS unsigned char* lds, int lane, int wave, bool dry = false, int pmode = 0) {
    unsigned char* ws = p.ws;
    const float* S = (const float*)(ws + WS_S); const float* ss2 = (const float*)(ws + WS_SS2);
    const bf16* X1B = (const bf16*)(ws + WS_X1B); const unsigned char* TU = ws + WS_TU; const unsigned char* TV = ws + WS_TV;
    LAS unsigned char* wl = lds + wave * PEER_WAVE_LDS;
    LAS float* sl = (LAS float*)wl;
    LAS int* kl = (LAS int*)(wl + 8192);
    LAS int* exl = (LAS int*)(wl + 18432);
    LAS float* gtl = (LAS float*)(wl + 18432 + 512);
    const int gw = blockIdx.x * NWAVES + wave, NGW = gridDim.x * NWAVES;
    const int IMIN = (int)0x80000000;
    int ci = 0, cb = 0;
    { const int th[15] = {16, 24, 29, 33, 36, 38, 40, 42, 43, 44, 45, 46, 47, 48, 49};
#pragma unroll
      for (int k = 0; k < 15; ++k) if (lane >= th[k]) { ci = k + 1; cb = th[k]; } }
    const int cj = (lane - cb) & 15; const bool cvalid = lane < 50;
    const __amdgpu_buffer_rsrc_t rsU = __builtin_amdgcn_make_buffer_rsrc((void*)TU, 0, -1, 0x00020000), rsV = __builtin_amdgcn_make_buffer_rsrc((void*)TV, 0, -1, 0x00020000);
    for (int t = gw; t < T; t += NGW) {
        const float rstd2 = rsqrtf(wave_sum(ss2[(size_t)t * 64 + lane]) * (1.0f / 4096.0f) + EPS);
#pragma unroll
        for (int c = 0; c < 8; ++c) { typedef _Float16 h4_t __attribute__((ext_vector_type(4)));
            const h4_t hv = *(const h4_t*)((const _Float16*)S + (size_t)t * 2048 + 256 * c + 4 * lane);
            const f32x4 svc = {(float)hv.x, (float)hv.y, (float)hv.z, (float)hv.w}; *(LAS f32x4*)(sl + 256 * c + 4 * lane) = svc; }
        LDS_WAIT();
#define PEER_CE(a, b) { const int hi_ = a > b ? a : b, lo_ = a > b ? b : a; a = hi_; b = lo_; }
#define PEER_POP(k, m) { const bool p_ = k[0] == m; k[0] = p_ ? k[1] : k[0]; k[1] = p_ ? k[2] : k[1]; k[2] = p_ ? k[3] : k[2]; k[3] = p_ ? IMIN : k[3]; }
#pragma unroll 1
        for (int c2 = 0; c2 < 4; ++c2) {
            int ka[4], kb[4]; { const int nb = 127 - 4 * (lane & 31); const f32x4 sa = *(const LAS f32x4*)(sl + 512 * c2 + 4 * lane), sb = *(const LAS f32x4*)(sl + 512 * c2 + 256 + 4 * lane);
#pragma unroll
              for (int e2 = 0; e2 < 4; ++e2) { ka[e2] = (f2ord(sa[e2]) & ~127) | (nb - e2); kb[e2] = (f2ord(sb[e2]) & ~127) | (nb - e2); } }
            PEER_CE(ka[0], ka[1]) PEER_CE(ka[2], ka[3]) PEER_CE(ka[0], ka[2]) PEER_CE(ka[1], ka[3]) PEER_CE(ka[1], ka[2])
            PEER_CE(kb[0], kb[1]) PEER_CE(kb[2], kb[3]) PEER_CE(kb[0], kb[2]) PEER_CE(kb[1], kb[3]) PEER_CE(kb[1], kb[2])
            int mineA = IMIN, mineB = IMIN;
#pragma unroll 1
            for (int it = 0; it < 16; ++it) {
                const int mA = half32_max_i(ka[0]), mB = half32_max_i(kb[0]);
                PEER_POP(ka, mA) PEER_POP(kb, mB)
                mineA = (lane & 31) == it ? mA : mineA; mineB = (lane & 31) == it ? mB : mineB;
            }
            if ((lane & 31) < 16) { kl[(4 * c2 + (lane >> 5)) * 16 + (lane & 31)] = mineA; kl[(4 * c2 + 2 + (lane >> 5)) * 16 + (lane & 31)] = mineB; }
        }
#undef PEER_CE
#undef PEER_POP
        LDS_WAIT();
#pragma unroll 1
        for (int h2 = 0; h2 < 4; ++h2) {
            int keyA, keyB;
            { const int hd = 2 * h2; const int ka = kl[(2 * hd) * 16 + ci], kb = kl[(2 * hd + 1) * 16 + cj];
              const float v = sl[(2 * hd) * 128 + 127 - (ka & 127)] + sl[(2 * hd + 1) * 128 + 127 - (kb & 127)]; keyA = cvalid ? ((f2ord(v) & ~255) | (255 - (ci * 16 + cj))) : IMIN; }
            { const int hd = 2 * h2 + 1; const int ka = kl[(2 * hd) * 16 + ci], kb = kl[(2 * hd + 1) * 16 + cj];
              const float v = sl[(2 * hd) * 128 + 127 - (ka & 127)] + sl[(2 * hd + 1) * 128 + 127 - (kb & 127)]; keyB = cvalid ? ((f2ord(v) & ~255) | (255 - (ci * 16 + cj))) : IMIN; }
            int mineA = IMIN, mineB = IMIN;
#pragma unroll 1
            for (int it = 0; it < 16; ++it) { const int mA = wave_max_fast_i(keyA), mB = wave_max_fast_i(keyB); keyA = keyA == mA ? IMIN : keyA; keyB = keyB == mB ? IMIN : keyB; mineA = lane == it ? mA : mineA; mineB = lane == it ? mB : mineB; }
#pragma unroll
            for (int q2 = 0; q2 < 2; ++q2) { const int hd = 2 * h2 + q2, mine = q2 ? mineB : mineA;
                const int fl = 255 - (mine & 255), wi = (fl >> 4) & 15, wj = fl & 15;
                const int k1 = kl[(2 * hd) * 16 + wi], k2 = kl[(2 * hd + 1) * 16 + wj];
                const int n1 = 127 - (k1 & 127), n2 = 127 - (k2 & 127);
                const float bv = sl[(2 * hd) * 128 + n1] + sl[(2 * hd + 1) * 128 + n2];
                const float bmax = __shfl(bv, 0);
                const float e = lane < 16 ? __expf((bv - bmax) * rstd2) : 0.f;
                const float es = wave_sum_fast(e);
                if (lane < 16) { exl[hd * 16 + lane] = n1 * 128 + n2; gtl[hd * 16 + lane] = e / es; } }
        }
        LDS_WAIT();
        { const int e0 = exl[lane], e1 = exl[64 + lane]; const float g0 = gtl[lane], g1 = gtl[64 + lane];
          const int k0 = e0 * 128 + lane, k1 = e1 * 128 + 64 + lane; int r0 = 0, r1 = 0;
#pragma unroll 4
          for (int i = 0; i < 128; i += 4) { const pg8::i32x4 v = *(const LAS pg8::i32x4*)(exl + i);
#pragma unroll
              for (int j = 0; j < 4; ++j) { const int ko = v[j] * 128 + i + j; r0 += ko < k0 ? 1 : 0; r1 += ko < k1 ? 1 : 0; } }
          LDS_WAIT(); asm volatile("" ::: "memory");
          const int flip = ((t / NGW) & 1) ? 127 : 0;
          r0 ^= flip; r1 ^= flip;
          exl[r0] = e0; gtl[r0] = g0; exl[r1] = e1; gtl[r1] = g1; }
        LDS_WAIT();
#if defined(PROBE_DUMP) && PROBE_DUMP == 3
        {
            float* orow = p.out + (size_t)t * D;
            for (int i = lane; i < 4096; i += 64) orow[i] = 0.f;
            orow[lane] = PROBE_DUMP_A * gtl[lane]; orow[64 + lane] = PROBE_DUMP_A * gtl[64 + lane];
            orow[128 + lane] = PROBE_DUMP_S * (float)exl[lane] * (1.0f / 16384.0f); orow[192 + lane] = PROBE_DUMP_S * (float)exl[64 + lane] * (1.0f / 16384.0f);
            if (lane == 0) orow[256] = rstd2;
            continue;
        }
#endif
        pg8::pg8_h2 oh[4][8]; v4u xq[3][2]; v4u xraw[4][2];
        { float xf[4][16];
#pragma unroll
          for (int c = 0; c < 4; ++c) { const v4u w0 = *(const v4u*)(X1B + (size_t)t * D + 1024 * c + 16 * lane), w1 = *(const v4u*)(X1B + (size_t)t * D + 1024 * c + 16 * lane + 8); xraw[c][0] = w0; xraw[c][1] = w1;
            xf[c][0] = bflo(w0.x); xf[c][1] = bfhi(w0.x); xf[c][2] = bflo(w0.y); xf[c][3] = bfhi(w0.y); xf[c][4] = bflo(w0.z); xf[c][5] = bfhi(w0.z); xf[c][6] = bflo(w0.w); xf[c][7] = bfhi(w0.w);
            xf[c][8] = bflo(w1.x); xf[c][9] = bfhi(w1.x); xf[c][10] = bflo(w1.y); xf[c][11] = bfhi(w1.y); xf[c][12] = bflo(w1.z); xf[c][13] = bfhi(w1.z); xf[c][14] = bflo(w1.w); xf[c][15] = bfhi(w1.w);
#pragma unroll
            for (int e = 0; e < 8; ++e) oh[c][e] = (pg8::pg8_h2){(_Float16)0.f, (_Float16)0.f}; }
          VM_WAIT();
#pragma unroll
          for (int c = 0; c < 4; ++c) { PIN(xraw[c][0]); PIN(xraw[c][1]); }
#define PEER_XQ(cc, d, b) { wq_ = __builtin_amdgcn_cvt_scalef32_pk_fp4_f32(wq_, clamp6(xf[cc][8 * d + 2 * b]), clamp6(xf[cc][8 * d + 2 * b + 1]), 1.0f, b); }
#define PEER_XR(cc, d, b) { const f32x2 dq_ = __builtin_amdgcn_cvt_scalef32_pk_f32_fp4(wq_, 1.0f, b); xf[cc][8 * d + 2 * b] = (xf[cc][8 * d + 2 * b] - dq_.x) * 8.0f; xf[cc][8 * d + 2 * b + 1] = (xf[cc][8 * d + 2 * b + 1] - dq_.y) * 8.0f; }
#pragma unroll
          for (int tq = 0; tq < 3; ++tq)
#pragma unroll
              for (int cc = 0; cc < 4; ++cc)
#pragma unroll
                  for (int d = 0; d < 2; ++d) { unsigned wq_ = 0;
                      PEER_XQ(cc, d, 0) PEER_XQ(cc, d, 1) PEER_XQ(cc, d, 2) PEER_XQ(cc, d, 3)
                      PEER_XR(cc, d, 0) PEER_XR(cc, d, 1) PEER_XR(cc, d, 2) PEER_XR(cc, d, 3)
                      xq[tq][cc >> 1][2 * (cc & 1) + d] = wq_; }
#undef PEER_XQ
#undef PEER_XR
        }
        const int lane16 = 16 * lane;
        const bool ondiag = ((lane & 15) >> 2) == (lane >> 4); const int drow = lane & 3;
        float dm0 = (ondiag && drow == 0) ? 1.0f : 0.0f, dm1 = (ondiag && drow == 1) ? 1.0f : 0.0f, dm2 = (ondiag && drow == 2) ? 1.0f : 0.0f, dm3 = (ondiag && drow == 3) ? 1.0f : 0.0f;
        asm volatile("" : "+v"(dm0), "+v"(dm1), "+v"(dm2), "+v"(dm3));
#define PEER_FILL(kk) do { const int eo_ = __builtin_amdgcn_readfirstlane(exl[(kk)]) * PEER_ROWB;     \
        LAS unsigned char* sl_ = wl + ((kk) & 3) * 4096; \
        __builtin_amdgcn_raw_ptr_buffer_load_lds(rsU, (LAS void*)(sl_), 16, lane16, eo_, 0, 0); __builtin_amdgcn_raw_ptr_buffer_load_lds(rsV, (LAS void*)(sl_ + 2048), 16, lane16, eo_, 0, 0); \
        __builtin_amdgcn_raw_ptr_buffer_load_lds(rsU, (LAS void*)(sl_ + 1024), 16, lane16, eo_ + 1024, 0, 0); __builtin_amdgcn_raw_ptr_buffer_load_lds(rsV, (LAS void*)(sl_ + 3072), 16, lane16, eo_ + 1024, 0, 0); } while (0)
#define PEER_V(VB, W2, q, dd, b) oh[2 * q + (dd >> 1)][4 * (dd & 1) + b] = __builtin_amdgcn_cvt_scalef32_pk_f16_fp4(VB[q][dd], 1.0f, b) * W2 + oh[2 * q + (dd >> 1)][4 * (dd & 1) + b]
#define PEER_ALLV(VB, W2) PEER_V(VB, W2, 0, 0, 0); PEER_V(VB, W2, 0, 0, 1); PEER_V(VB, W2, 0, 0, 2); PEER_V(VB, W2, 0, 0, 3); PEER_V(VB, W2, 0, 1, 0); PEER_V(VB, W2, 0, 1, 1); PEER_V(VB, W2, 0, 1, 2); PEER_V(VB, W2, 0, 1, 3); \
                          PEER_V(VB, W2, 0, 2, 0); PEER_V(VB, W2, 0, 2, 1); PEER_V(VB, W2, 0, 2, 2); PEER_V(VB, W2, 0, 2, 3); PEER_V(VB, W2, 0, 3, 0); PEER_V(VB, W2, 0, 3, 1); PEER_V(VB, W2, 0, 3, 2); PEER_V(VB, W2, 0, 3, 3); \
                          PEER_V(VB, W2, 1, 0, 0); PEER_V(VB, W2, 1, 0, 1); PEER_V(VB, W2, 1, 0, 2); PEER_V(VB, W2, 1, 0, 3); PEER_V(VB, W2, 1, 1, 0); PEER_V(VB, W2, 1, 1, 1); PEER_V(VB, W2, 1, 1, 2); PEER_V(VB, W2, 1, 1, 3); \
                          PEER_V(VB, W2, 1, 2, 0); PEER_V(VB, W2, 1, 2, 1); PEER_V(VB, W2, 1, 2, 2); PEER_V(VB, W2, 1, 2, 3); PEER_V(VB, W2, 1, 3, 0); PEER_V(VB, W2, 1, 3, 1); PEER_V(VB, W2, 1, 3, 2); PEER_V(VB, W2, 1, 3, 3)
#define PEER_DOT(UB, DG) { const pg8::i32x8 ua0 = {(int)UB[0].x, (int)UB[0].y, (int)UB[0].z, (int)UB[0].w, 0, 0, 0, 0}, ua1 = {(int)UB[1].x, (int)UB[1].y, (int)UB[1].z, (int)UB[1].w, 0, 0, 0, 0}; \
              _Pragma("unroll") for (int tq = 0; tq < 3; ++tq) { const int sc = tq == 0 ? 0x7f7f7f7f : (tq == 1 ? 0x7c7c7c7c : 0x79797979); \
                DG = __builtin_amdgcn_mfma_scale_f32_16x16x128_f8f6f4(ua0, (pg8::i32x8){(int)xq[tq][0].x, (int)xq[tq][0].y, (int)xq[tq][0].z, (int)xq[tq][0].w, 0, 0, 0, 0}, DG, 4, 4, 0, 0x7f7f7f7f, 0, sc); \
                DG = __builtin_amdgcn_mfma_scale_f32_16x16x128_f8f6f4(ua1, (pg8::i32x8){(int)xq[tq][1].x, (int)xq[tq][1].y, (int)xq[tq][1].z, (int)xq[tq][1].w, 0, 0, 0, 0}, DG, 4, 4, 0, 0x7f7f7f7f, 0, sc); } }
        const bool oddl = (lane & 1) != 0;
        if (pmode != 2) { PEER_FILL(0); PEER_FILL(1); PEER_FILL(2); PEER_FILL(3); }
#pragma unroll 1
        for (int k = 0; k < (PROBE_SKIP_PEER ? 0 : 128); k += 2) {
            if (pmode != 2) { if (k < 126) asm volatile("s_waitcnt vmcnt(8)" ::: "memory"); else asm volatile("s_waitcnt vmcnt(0)" ::: "memory"); }
            const LAS unsigned char* spA = wl + (k & 3) * 4096 + 16 * lane; const LAS unsigned char* spB = wl + ((k + 1) & 3) * 4096 + 16 * lane;
            v4u ubA[2], vbA[2], ubB[2], vbB[2];
#pragma unroll
            for (int c = 0; c < 2; ++c) { ubA[c] = *(const LAS v4u*)(spA + 1024 * c); ubB[c] = *(const LAS v4u*)(spB + 1024 * c); }
#pragma unroll
            for (int c = 0; c < 2; ++c) { vbA[c] = *(const LAS v4u*)(spA + 2048 + 1024 * c); vbB[c] = *(const LAS v4u*)(spB + 2048 + 1024 * c); }
            const float gate = gtl[k + (lane & 1)];
            LDS_WAIT();
            asm volatile("" : "+v"(vbA[0]), "+v"(vbA[1]), "+v"(vbB[0]), "+v"(vbB[1]));
            if (pmode != 2 && k < 124) { PEER_FILL(k + 4); PEER_FILL(k + 5); }
            f32x4 dgA = {0.f, 0.f, 0.f, 0.f}, dgB = {0.f, 0.f, 0.f, 0.f};
            PEER_DOT(ubA, dgA) PEER_DOT(ubB, dgB)
            asm volatile("" : "+v"(dgA), "+v"(dgB) : "v"(ubA[0]), "v"(ubA[1]), "v"(ubB[0]), "v"(ubB[1]));
            const float pA = dgA[0] * dm0 + dgA[1] * dm1 + dgA[2] * dm2 + dgA[3] * dm3, pB = dgB[0] * dm0 + dgB[1] * dm1 + dgB[2] * dm2 + dgB[3] * dm3;
            float r = (oddl ? pB : pA) + __int_as_float(DPP_I(__float_as_int(oddl ? pA : pB), 0xB1));
            r += __int_as_float(DPP_I(__float_as_int(r), 0x4E)); r += __int_as_float(DPP_I(__float_as_int(r), 0x124)); r += __int_as_float(DPP_I(__float_as_int(r), 0x128));
            { const int v = __float_as_int(r); const auto s16 = __builtin_amdgcn_permlane16_swap((unsigned)v, (unsigned)v, false, false); r = __uint_as_float(s16[0]) + __uint_as_float(s16[1]); }
            { const int v = __float_as_int(r); const auto s32 = __builtin_amdgcn_permlane32_swap((unsigned)v, (unsigned)v, false, false); r = __uint_as_float(s32[0]) + __uint_as_float(s32[1]); }
            const float wgt = PROBE_SP * gate * pg8::gelu_tanh(r * (rstd2 * (1.0f / PEER_SU))) * (1.0f / PEER_SV);
            const pg8::pg8_h2 w2 = {(_Float16)wgt, (_Float16)wgt}; const int w2i = (int)__builtin_bit_cast(unsigned, w2);
            const pg8::pg8_h2 w2A = __builtin_bit_cast(pg8::pg8_h2, (unsigned)__builtin_amdgcn_update_dpp(0, w2i, 0xA0, 0xF, 0xF, true)), w2B = __builtin_bit_cast(pg8::pg8_h2, (unsigned)__builtin_amdgcn_update_dpp(0, w2i, 0xF5, 0xF, 0xF, true));
            PEER_ALLV(vbA, w2A);
            PEER_ALLV(vbB, w2B);
        }
        asm volatile("s_waitcnt vmcnt(0)" ::: "memory");
#undef PEER_FILL
#undef PEER_V
#undef PEER_ALLV
#undef PEER_DOT
        float ov[4][16];
#pragma unroll
        for (int c = 0; c < 4; ++c)
#pragma unroll
            for (int e = 0; e < 8; ++e) { ov[c][2 * e] = (float)oh[c][e].x; ov[c][2 * e + 1] = (float)oh[c][e].y; }
        float* orow = p.out + (size_t)t * D; float sq = 0.f;
#pragma unroll
        for (int c = 0; c < 4; ++c) { f32x4 a[4];
            a[0] = (f32x4){bflo(xraw[c][0].x), bfhi(xraw[c][0].x), bflo(xraw[c][0].y), bfhi(xraw[c][0].y)}; a[1] = (f32x4){bflo(xraw[c][0].z), bfhi(xraw[c][0].z), bflo(xraw[c][0].w), bfhi(xraw[c][0].w)};
            a[2] = (f32x4){bflo(xraw[c][1].x), bfhi(xraw[c][1].x), bflo(xraw[c][1].y), bfhi(xraw[c][1].y)}; a[3] = (f32x4){bflo(xraw[c][1].z), bfhi(xraw[c][1].z), bflo(xraw[c][1].w), bfhi(xraw[c][1].w)};
#pragma unroll
            for (int j = 0; j < 4; ++j)
#pragma unroll
                for (int e = 0; e < 4; ++e) { ov[c][4 * j + e] += a[j][e]; sq += ov[c][4 * j + e] * ov[c][4 * j + e]; } }
        sq = wave_sum(sq);
        const float rf = rsqrtf(sq * (1.0f / 4096.0f) + EPS);
#pragma unroll
        for (int c = 0; c < 4; ++c) { f32x4 g[4];
#pragma unroll
            for (int j = 0; j < 4; ++j) g[j] = *(const f32x4*)(p.norm_final_g + 1024 * c + 16 * lane + 4 * j);
#pragma unroll
            for (int j = 0; j < 4; ++j) PIN(g[j]);
#pragma unroll
            for (int j = 0; j < 4; ++j) if (!dry || rf == -1.0f) *(f32x4*)(orow + 1024 * c + 16 * lane + 4 * j) = (f32x4){ov[c][4 * j] * rf * g[j][0], ov[c][4 * j + 1] * rf * g[j][1], ov[c][4 * j + 2] * rf * g[j][2], ov[c][4 * j + 3] * rf * g[j][3]}; }
    }
}

__global__ void __launch_bounds__(NWAVES * 64, 2) fwd(Params p) {
    extern __shared__ __attribute__((aligned(16))) unsigned char lds_raw[];
    LAS unsigned char* lds = (LAS unsigned char*)lds_raw;
    const int tid = threadIdx.x, lane = tid & 63, wave = __builtin_amdgcn_readfirstlane(tid >> 6);
    unsigned char* ws = p.ws;
    if (tid < 64) ((LAS unsigned*)(lds + LDS_MISC))[tid] = 0u;
#if defined(PROBE_FENCES)
    __builtin_amdgcn_fence(__ATOMIC_ACQUIRE, PROBE_SCOPE); asm volatile("s_waitcnt vmcnt(0)" ::: "memory");
#endif
    __syncthreads();
    const int lo = p.ph_lo, hi = p.ph_hi;
    XcdBarrier bar; bar.bar = (unsigned*)(ws + WS_CTL) + CW_BAR + p.li * XCD_BAR_WORDS; bar.x = 0; bar.st = nullptr;
    if (hi - lo > 1) bar = xcd_barrier_post((unsigned*)(ws + WS_CTL) + CW_BAR + p.li * XCD_BAR_WORDS, (volatile LAS unsigned*)(lds + LDS_MISC) + 8);
#define IN(k) (lo <= (k) && (k) < hi)
#define SEAM(k) do { if (IN(k) && IN((k) + 1)) xcd_barrier(bar); } while (0)
    const int G = gridDim.x;

    if (IN(0)) { p0_prologue(p, lds, tid, lane, wave); if (PROBE_DUP == 0) { xcd_barrier(bar); p0_prologue(p, lds, tid, lane, wave); } }
    SEAM(0);
    if (IN(1)) {
        const pg8::EpiIn E0{(const float*)(ws + WS_SS1), (const float*)(ws + WS_COS), (const float*)(ws + WS_SIN), p.b_gate, (float*)(ws + CB_KACC), 0, 1.0f, (bf16*)(ws + WS_Q), (bf16*)(ws + WS_G)};
        const pg8::EpiIn E1{(const float*)(ws + WS_SS1), (const float*)(ws + WS_COS), (const float*)(ws + WS_SIN), p.b_gate, (float*)(ws + CB_KACC), 1, 1.0f / (S_X * S_W1), (bf16*)(ws + WS_Q), (bf16*)(ws + WS_G)};
        static_assert(WS_K - WS_Q == (size_t)T * 2048 * 2 && WS_V - WS_K == WS_K - WS_Q && WS_U - WS_V == WS_K - WS_Q && WS_GV - WS_U == WS_K - WS_Q, "q|k|v|u|gv contiguous");
#if ZUZV_FP8
        { const pg8::EpiIn E2{(const float*)(ws + WS_SS1), (const float*)(ws + WS_COS), (const float*)(ws + WS_SIN), p.b_gate, (float*)(ws + CB_KACC), 2, 1.0f / (S_X * S_W1), (bf16*)(ws + WS_Q), (bf16*)(ws + WS_G)};
          pg8::Gemm g{(const bf16*)(ws + WS_XB8), (const bf16*)(ws + WS_W18), T, N1, D}; pg8::StaticOrder S; S.init(T, N1, G, (int)blockIdx.x);
          pg8::gemm_phase<pg8::EpiIn, pg8::StaticOrder, true, true, true>(lds, g, S, E2); (void)E0; (void)E1; }
#if PROBE_DUP == 11
          { xcd_barrier(bar); const pg8::EpiNull EN{};
            pg8::Gemm g{(const bf16*)(ws + WS_XB8), (const bf16*)(ws + WS_W18), T, N1, D}; pg8::StaticOrder S; S.init(T, N1, G, (int)blockIdx.x);
            pg8::gemm_phase<pg8::EpiNull, pg8::StaticOrder, true, true, true>(lds, g, S, EN); }
#endif
#if PROBE_DUP == 1
          { xcd_barrier(bar); const pg8::EpiIn E2{(const float*)(ws + WS_SS1), (const float*)(ws + WS_COS), (const float*)(ws + WS_SIN), p.b_gate, (float*)(ws + CB_KACC), 2, 1.0f / (S_X * S_W1), (bf16*)(ws + WS_Q), (bf16*)(ws + WS_G)};
            pg8::Gemm g{(const bf16*)(ws + WS_XB8), (const bf16*)(ws + WS_W18), T, N1, D}; pg8::StaticOrder S; S.init(T, N1, G, (int)blockIdx.x);
            pg8::gemm_phase<pg8::EpiIn, pg8::StaticOrder, true, true, true>(lds, g, S, E2); }
#endif
#else
        { pg8::Gemm g{(const bf16*)(ws + WS_XB), (const bf16*)(ws + WS_W1Z), T, 4096, D}; pg8::StaticOrder S; S.init(T, 4096, G, (int)blockIdx.x);
          pg8::gemm_phase<pg8::EpiIn, pg8::StaticOrder, true, true>(lds, g, S, E0); }
        { pg8::Gemm g{(const bf16*)(ws + WS_XB8), (const bf16*)(ws + WS_W18), T, 14336, D}; pg8::StaticOrder S; S.init(T, 14336, G, (int)blockIdx.x);
          pg8::gemm_phase<pg8::EpiIn, pg8::StaticOrder, true, true, true>(lds, g, S, E1); }
#endif
    }
    SEAM(1);
#if defined(PROBE_GATECHK)
    if (IN(2)) {
        float* accum = (float*)(ws + 147456);
        const float* ss1 = (const float*)(ws + WS_SS1); const bf16* Gm = (const bf16*)(ws + WS_G);
        const int gw2 = blockIdx.x * NWAVES + wave, NGW2 = gridDim.x * NWAVES; float num = 0.f, den = 0.f;
        for (int task = gw2; task < 128 * 128; task += NGW2) { const int t = PROBE_T0 + PROBE_TSTRIDE * (task >> 7), n = (task & 127) * 64 + lane;
            float s = 0.f; for (int k = 0; k < D; ++k) s += p.x[(size_t)t * D + k] * p.norm_mix_g[k] * p.w_gate[(size_t)k * GWD + n];
            const float rs = rsqrtf(ss1[t] * (1.0f / 4096.0f) + EPS); const float ref = 1.0f / (1.0f + __expf(-(s * rs + p.b_gate[n])));
            const float mine = __uint_as_float((unsigned)Gm[(size_t)t * GWD + (n ^ PROBE_XOR)] << 16);
            num += (mine - ref) * (mine - ref); den += ref * ref; }
        num = wave_sum(num); den = wave_sum(den);
        if (lane == 0) { atomicAdd(accum, num); atomicAdd(accum + 1, den); }
        xcd_barrier(bar);
        const float c = PROBE_K * sqrtf(__hip_atomic_load(accum, __ATOMIC_RELAXED, __HIP_MEMORY_SCOPE_AGENT) / __hip_atomic_load(accum + 1, __ATOMIC_RELAXED, __HIP_MEMORY_SCOPE_AGENT));
        for (size_t i = (size_t)blockIdx.x * 512 + tid; i < (size_t)T * D; i += (size_t)gridDim.x * 512) p.out[i] = c;
        return;
    }
#endif
    if (IN(2)) {
        for (int u = blockIdx.x; u < 1024; u += 4 * G) moba_select_multi<4>(p, u, G, lane, wave);
        for (int u = blockIdx.x; u < 2048; u += G) sgu_unit(p, lds, u >> 4, u & 15, tid, lane, wave);
        if (PROBE_DUP == 2) { xcd_barrier(bar); for (int u = blockIdx.x; u < 2048; u += G) sgu_unit(p, lds, u >> 4, u & 15, tid, lane, wave); }
    }
    SEAM(2);
    if (IN(3)) { attn_phase(p, lds, tid, lane, wave); if (PROBE_DUP == 3) { xcd_barrier(bar); attn_phase(p, lds, tid, lane, wave); } }
    SEAM(3);
    if (IN(4)) { attn_combine(p, lane, wave); peer_tables(p, tid); if (PROBE_DUP == 4) { xcd_barrier(bar); attn_combine(p, lane, wave); peer_tables(p, tid); } }
    SEAM(4);
    if (IN(5)) {
        { pg8::Gemm g{(const bf16*)(ws + WS_AO8), (const bf16*)(ws + WS_WAP), T, D, AW}; pg8::StaticOrder S; S.init(T, D, G, (int)blockIdx.x);
          pg8::EpiMix<0> E{(const bf16*)(ws + WS_G), (bf16*)(ws + WS_MIX), (bf16*)(ws + WS_X1B), 1.0f / (S_AO * S_WAP), 1.0f};
          pg8::gemm_phase<pg8::EpiMix<0>, pg8::StaticOrder, true, true, true>(lds, g, S, E); }
        { pg8::Gemm g{(const bf16*)(ws + WS_SO), (const bf16*)(ws + WS_WSP), T, D, AW}; pg8::StaticOrder S; S.init(T, D, G, (int)blockIdx.x);
          pg8::EpiMix<1> E{(const bf16*)(ws + WS_G), (bf16*)(ws + WS_MIX), (bf16*)(ws + WS_X1B), SGU_FP8 ? 1.0f / (S_SO * S_WSP) : 1.0f, S_MIX};
          pg8::gemm_phase<pg8::EpiMix<1>, pg8::StaticOrder, true, true, SGU_FP8 != 0>(lds, g, S, E); }
    #if PROBE_DUP == 567 || PROBE_DUP == 5
        xcd_barrier(bar);
        {
        { pg8::Gemm g{(const bf16*)(ws + WS_AO8), (const bf16*)(ws + WS_WAP), T, D, AW}; pg8::StaticOrder S; S.init(T, D, G, (int)blockIdx.x);
          pg8::EpiMix<0> E{(const bf16*)(ws + WS_G), (bf16*)(ws + WS_MIX), (bf16*)(ws + WS_X1B), 1.0f / (S_AO * S_WAP), 1.0f};
          pg8::gemm_phase<pg8::EpiMix<0>, pg8::StaticOrder, true, true, true>(lds, g, S, E); }
        { pg8::Gemm g{(const bf16*)(ws + WS_SO), (const bf16*)(ws + WS_WSP), T, D, AW}; pg8::StaticOrder S; S.init(T, D, G, (int)blockIdx.x);
          pg8::EpiMix<1> E{(const bf16*)(ws + WS_G), (bf16*)(ws + WS_MIX), (bf16*)(ws + WS_X1B), SGU_FP8 ? 1.0f / (S_SO * S_WSP) : 1.0f, S_MIX};
          pg8::gemm_phase<pg8::EpiMix<1>, pg8::StaticOrder, true, true, SGU_FP8 != 0>(lds, g, S, E); }
    }
#endif
    }
    SEAM(5);
#ifndef PROBE_SKIP_P6
#define PROBE_SKIP_P6 0
#endif
    if (IN(6) && !PROBE_SKIP_P6) {
        pg8::Gemm g{(const bf16*)(ws + WS_MIX), (const bf16*)(ws + WS_WO), T, D, D}; pg8::StaticOrder S; S.init(T, D, G, (int)blockIdx.x);
        pg8::EpiWo E{(const float*)(ws + WS_XBF), p.out, (bf16*)(ws + WS_X1B), (float*)(ws + WS_SS2), 1.0f / (S_MIX * S_WO)};
        #ifndef PROBE_P6_ALIGN
#define PROBE_P6_ALIGN true
#endif
#ifndef PROBE_P6_SP2
#define PROBE_P6_SP2 true
#endif
        pg8::gemm_phase<pg8::EpiWo, pg8::StaticOrder, true, true, true>(lds, g, S, E);
    #if PROBE_DUP == 567 || PROBE_DUP == 6
        xcd_barrier(bar);
        {
        pg8::Gemm g{(const bf16*)(ws + WS_MIX), (const bf16*)(ws + WS_WO), T, D, D}; pg8::StaticOrder S; S.init(T, D, G, (int)blockIdx.x);
        pg8::EpiWo E{(const float*)(ws + WS_XBF), p.out, (bf16*)(ws + WS_X1B), (float*)(ws + WS_SS2), 1.0f / (S_MIX * S_WO)};
        #ifndef PROBE_P6_ALIGN
#define PROBE_P6_ALIGN true
#endif
#ifndef PROBE_P6_SP2
#define PROBE_P6_SP2 true
#endif
        pg8::gemm_phase<pg8::EpiWo, pg8::StaticOrder, true, true, true>(lds, g, S, E);
    }
#endif
    }
    SEAM(6);
#if defined(PROBE_DUMP) && PROBE_DUMP == 8
    if (IN(PROBE_AT)) {
        const int gw2 = blockIdx.x * NWAVES + wave, NGW2 = gridDim.x * NWAVES;
        for (int t = gw2; t < T; t += NGW2) { const bf16* Ap = (const bf16*)(ws + WS_MIX) + (size_t)t * 4096; float* orow = p.out + (size_t)t * D;
            for (int i = lane; i < 4096; i += 64) orow[i] = (float)(((unsigned)Ap[i] * 2654435761u) >> 16) * (1.0f / 65536.0f); }
        return;
    }
    if (IN(8) && PROBE_AT != 8) return;
#endif
    if (IN(7)) {
        #ifndef PROBE_P7_A
#define PROBE_P7_A WS_X1B
#endif
#ifndef PROBE_P7_B
#define PROBE_P7_B WS_W2
#endif
        pg8::Gemm g{(const bf16*)(ws + PROBE_P7_A), (const bf16*)(ws + PROBE_P7_B), T, 2048, D}; pg8::StaticOrder S; S.init(T, 2048, G, (int)blockIdx.x);
        pg8::EpiS E{(float*)(ws + WS_S)};
        pg8::gemm_phase<pg8::EpiS, pg8::StaticOrder, true, true>(lds, g, S, E);
    #if PROBE_DUP == 567 || PROBE_DUP == 7
        xcd_barrier(bar);
        {
        #ifndef PROBE_P7_A
#define PROBE_P7_A WS_X1B
#endif
#ifndef PROBE_P7_B
#define PROBE_P7_B WS_W2
#endif
        pg8::Gemm g{(const bf16*)(ws + PROBE_P7_A), (const bf16*)(ws + PROBE_P7_B), T, 2048, D}; pg8::StaticOrder S; S.init(T, 2048, G, (int)blockIdx.x);
        pg8::EpiS E{(float*)(ws + WS_S)};
        pg8::gemm_phase<pg8::EpiS, pg8::StaticOrder, true, true>(lds, g, S, E);
    }
#endif
    }
    SEAM(7);
#if 0
#else
    if (IN(8)) { if (PROBE_DUP == 8) { peer_phase(p, lds, lane, wave, true, PROBE_PMODE); xcd_barrier(bar); } peer_phase(p, lds, lane, wave); }
#endif
#if defined(PROBE_FENCES)
    asm volatile("s_waitcnt vmcnt(0)" ::: "memory"); __syncthreads();
    if (tid == 0) { __builtin_amdgcn_fence(__ATOMIC_RELEASE, PROBE_SCOPE); asm volatile("s_waitcnt vmcnt(0)" ::: "memory"); }
#endif
#undef IN
#undef SEAM
}

extern "C" void kernel_launch(void* const* d_in, const int* in_sizes, int n_in, void* d_out, int out_size, void* d_ws, size_t ws_size, hipStream_t stream) {
    static int grid = 0;
    if (grid == 0) {
        if (n_in != 17 || out_size != T * D || ws_size < WS_END) { fprintf(stderr, "kernel_launch: unexpected shapes (n_in %d, out %d, ws %zu)\n", n_in, out_size, ws_size); grid = -1; return; }
        int dev = 0, cus = 0, per_cu = 0;
        if (hipGetDevice(&dev) != hipSuccess || hipDeviceGetAttribute(&cus, hipDeviceAttributeMultiprocessorCount, dev) != hipSuccess) { grid = -1; return; }
        if (hipFuncSetAttribute((const void*)fwd, hipFuncAttributeMaxDynamicSharedMemorySize, LDS_BYTES) != hipSuccess) { fprintf(stderr, "kernel_launch: hipFuncSetAttribute failed\n"); grid = -1; return; }
        if (hipOccupancyMaxActiveBlocksPerMultiprocessor(&per_cu, (const void*)fwd, NWAVES * 64, LDS_BYTES) != hipSuccess || per_cu < 1) { fprintf(stderr, "kernel_launch: occupancy query says %d\n", per_cu); (void)hipGetLastError(); per_cu = 1; }
        grid = cus;
    }
    if (grid < 0) return;
    (void)hipMemsetAsync((char*)d_ws + WS_CTL, 0, CTL_ZERO_BYTES, stream);
    Params a{};
    a.x = (const float*)d_in[0]; a.norm_mix_g = (const float*)d_in[1]; a.w_in = (const float*)d_in[2]; a.w_attn_proj = (const float*)d_in[3]; a.sgu_norm_g = (const float*)d_in[4];
    a.sgu_w = (const float*)d_in[5]; a.sgu_b = (const float*)d_in[6]; a.w_sgu_proj = (const float*)d_in[7]; a.w_gate = (const float*)d_in[8]; a.b_gate = (const float*)d_in[9];
    a.w_o = (const float*)d_in[10]; a.norm_ffn_g = (const float*)d_in[11]; a.peer_wq = (const float*)d_in[12]; a.peer_subkeys = (const float*)d_in[13]; a.peer_u = (const float*)d_in[14];
    a.peer_v = (const float*)d_in[15]; a.norm_final_g = (const float*)d_in[16];
    a.out = (float*)d_out; a.ws = (unsigned char*)d_ws;
    for (int li = 0; li < N_LAUNCH; ++li) {
        a.ph_lo = (N_LAUNCH == 1) ? 0 : li; a.ph_hi = (N_LAUNCH == 1) ? NPHASE : li + 1; a.li = li; a.pad = 0;
        hipLaunchKernelGGL(fwd, dim3(grid), dim3(NWAVES * 64), LDS_BYTES, stream, a);
#if defined(PROBE_REPEAT_P6)
        if (N_LAUNCH != 1 && li == 6) hipLaunchKernelGGL(fwd, dim3(grid), dim3(NWAVES * 64), LDS_BYTES, stream, a);
#endif
        const hipError_t le = hipPeekAtLastError();
        if (le != hipSuccess) { fprintf(stderr, "kernel_launch: launch %d failed: %s\n", li, hipGetErrorName(le)); break; }
    }
}
```
